# Optimizing an MI355X kernel written in HIP

```python
import math
import jax, jax.numpy as jnp
from jax import lax
import numpy as np

D_MODEL = 1024
BATCH = 4
SEQ = 8192
DEPTH = 1
DEC_BATCH = 16
DEC_SEQ = 16
PAST_LEN = 2048

CHUNK = 64
Q_BLOCK = 128
FOX_HEADS = 8
FOX_HEAD_DIM = 64
FOX_WIDTH = FOX_HEADS * FOX_HEAD_DIM
GDN_HEADS = 8
GDN_DK = 64
GDN_DV = 64
GDN_KW = GDN_HEADS * GDN_DK
GDN_VW = GDN_HEADS * GDN_DV
GDN_CONV_DIM = 2 * GDN_KW + GDN_VW
CONV_WIDTH = 4
D_FF = 4 * D_MODEL
IN_WIDTH = 3 * FOX_WIDTH + FOX_HEADS + GDN_CONV_DIM + 2 * GDN_HEADS + GDN_VW + 2 * D_MODEL
EPS = 1e-6

kernel_name = 'hybrid_fox_gdn_stream_step'

F32 = jnp.float32


def rmsnorm(x, gain):
    xf = x.astype(F32)
    y = xf * lax.rsqrt(jnp.mean(xf * xf, axis=-1, keepdims=True) + EPS)
    return (y * gain.astype(F32)).astype(x.dtype)


def l2norm(x):
    xf = x.astype(F32)
    return xf * lax.rsqrt(jnp.sum(xf * xf, axis=-1, keepdims=True) + EPS)


def short_conv(x_ext, w):
    t = x_ext.shape[1] - (CONV_WIDTH - 1)
    y = x_ext[:, 0:t] * w[0]
    for i in range(1, CONV_WIDTH):
        y = y + x_ext[:, i:i + t] * w[i]
    return jax.nn.silu(y)


def in_project(h, w_in, forget_bias, a_log, dt_bias):
    b, t = h.shape[0], h.shape[1]
    sizes = (FOX_WIDTH, FOX_WIDTH, FOX_WIDTH, FOX_HEADS, GDN_CONV_DIM, GDN_HEADS, GDN_HEADS, GDN_VW, D_MODEL, D_MODEL)
    points = [int(p) for p in np.cumsum(sizes)[:-1]]
    z = jnp.einsum('btd,de->bte', h, w_in)
    fq, fk, fv, ff, gqkv, ga, gb, gg, gate_a, gate_b = jnp.split(z, points, axis=-1)
    fq = fq.reshape(b, t, FOX_HEADS, FOX_HEAD_DIM)
    fk = fk.reshape(b, t, FOX_HEADS, FOX_HEAD_DIM)
    fv = fv.reshape(b, t, FOX_HEADS, FOX_HEAD_DIM)
    logf = jax.nn.log_sigmoid(ff.astype(F32) + forget_bias.astype(F32))
    g = -jnp.exp(a_log.astype(F32)) * jax.nn.softplus(ga.astype(F32) + dt_bias.astype(F32))
    beta = jax.nn.sigmoid(gb.astype(F32))
    return fq, fk, fv, logf, gqkv, g, beta, gg, gate_a, gate_b


def gdn_heads(conv_out):
    b, t = conv_out.shape[0], conv_out.shape[1]
    q = conv_out[..., :GDN_KW].reshape(b, t, GDN_HEADS, GDN_DK)
    k = conv_out[..., GDN_KW:2 * GDN_KW].reshape(b, t, GDN_HEADS, GDN_DK)
    v = conv_out[..., 2 * GDN_KW:].reshape(b, t, GDN_HEADS, GDN_DV)
    return l2norm(q) * (GDN_DK ** -0.5), l2norm(k), v.astype(F32)


def fox_prompt(q, k, v, logf):
    b, s = q.shape[0], q.shape[1]
    nblk = s // Q_BLOCK
    scale = FOX_HEAD_DIM ** -0.5
    ft = jnp.cumsum(logf, axis=1).transpose(0, 2, 1)
    q_blocks = jnp.moveaxis(q.reshape(b, nblk, Q_BLOCK, FOX_HEADS, FOX_HEAD_DIM), 1, 0)
    f_blocks = jnp.moveaxis(ft.reshape(b, FOX_HEADS, nblk, Q_BLOCK), 2, 0)
    kpos = jnp.arange(s)

    def one_block(args):
        blk, q_blk, f_blk = args
        sc = jnp.einsum('bqhd,bkhd->bhqk', q_blk, k).astype(F32) * scale
        sc = sc + f_blk[..., :, None] - ft[..., None, :]
        qpos = blk * Q_BLOCK + jnp.arange(Q_BLOCK)
        sc = jnp.where(kpos[None, :] <= qpos[:, None], sc, -jnp.inf)
        p = jax.nn.softmax(sc, axis=-1)
        return jnp.einsum('bhqk,bkhd->bqhd', p.astype(v.dtype), v)

    out = lax.map(one_block, (jnp.arange(nblk), q_blocks, f_blocks))
    return jnp.moveaxis(out, 0, 1).reshape(b, s, FOX_HEADS, FOX_HEAD_DIM)


def fox_sample(q, k, v, logf, past):
    t = q.shape[1]
    scale = FOX_HEAD_DIM ** -0.5
    ft = jnp.cumsum(logf, axis=1).transpose(0, 2, 1)
    sc = jnp.einsum('bqhd,bkhd->bhqk', q, k).astype(F32) * scale
    sc = sc + ft[..., past:, None] - ft[..., None, :]
    mask = jnp.arange(past + t)[None, :] <= (past + jnp.arange(t))[:, None]
    p = jax.nn.softmax(jnp.where(mask, sc, -jnp.inf), axis=-1)
    return jnp.einsum('bhqk,bkhd->bqhd', p.astype(v.dtype), v)


def gdn_chunk(state, q, k, v, g, beta):
    q = q.transpose(0, 2, 1, 3)
    k = k.transpose(0, 2, 1, 3)
    v = v.transpose(0, 2, 1, 3)
    g = g.transpose(0, 2, 1)
    beta = beta.transpose(0, 2, 1)
    c = q.shape[2]
    gc = jnp.cumsum(g, axis=-1)
    pos = jnp.arange(c)
    incl = pos[:, None] >= pos[None, :]
    strict = pos[:, None] > pos[None, :]
    decay = jnp.exp(jnp.where(incl, gc[..., :, None] - gc[..., None, :], -jnp.inf))
    kb = k * beta[..., None]
    lower = jnp.einsum('bhik,bhjk->bhij', kb, k) * jnp.where(strict, decay, 0.0)
    rhs = jnp.concatenate([v * beta[..., None], kb * jnp.exp(gc)[..., None]], axis=-1)
    sol = lax.linalg.triangular_solve(lower, rhs, left_side=True, lower=True, unit_diagonal=True)
    u, w = sol[..., :GDN_DV], sol[..., GDN_DV:]
    v_new = u - jnp.einsum('bhck,bhkv->bhcv', w, state)
    o = (jnp.einsum('bhck,bhkv->bhcv', q * jnp.exp(gc)[..., None], state)
         + jnp.einsum('bhij,bhjv->bhiv', jnp.einsum('bhik,bhjk->bhij', q, k) * decay, v_new))
    g_last = gc[..., -1:]
    new_state = (state * jnp.exp(g_last)[..., None]
                 + jnp.einsum('bhck,bhcv->bhkv', k * jnp.exp(g_last - gc)[..., None], v_new))
    return new_state, o.transpose(0, 2, 1, 3)


def gdn_prompt(q, k, v, g, beta):
    b, s = q.shape[0], q.shape[1]
    n = s // CHUNK
    to_chunks = lambda a: jnp.moveaxis(a.reshape((b, n, CHUNK) + a.shape[2:]), 1, 0)
    xs = (to_chunks(q), to_chunks(k), to_chunks(v), to_chunks(g), to_chunks(beta))
    s0 = jnp.zeros((b, GDN_HEADS, GDN_DK, GDN_DV), F32)

    def step(st, args):
        return gdn_chunk(st, *args)

    s_fin, o = lax.scan(step, s0, xs)
    return s_fin, jnp.moveaxis(o, 0, 1).reshape(b, s, GDN_HEADS, GDN_DV)


def merge(fox_o, gdn_o, gg, gate_a, gate_b, norm_g, w_pa, w_pb, w_out):
    b, t = fox_o.shape[0], fox_o.shape[1]
    ya = fox_o.reshape(b, t, FOX_WIDTH) @ w_pa
    o = rmsnorm(gdn_o, norm_g) * jax.nn.silu(gg.reshape(b, t, GDN_HEADS, GDN_DV).astype(F32))
    yb = o.reshape(b, t, GDN_VW).astype(ya.dtype) @ w_pb
    m = jax.nn.sigmoid(gate_a) * ya + jax.nn.sigmoid(gate_b) * yb
    return m @ w_out


def mixer_prompt(h, w_in, forget_bias, conv_w, a_log, dt_bias, norm_g, w_pa, w_pb, w_out):
    fq, fk, fv, logf, gqkv, g, beta, gg, gate_a, gate_b = in_project(h, w_in, forget_bias, a_log, dt_bias)
    fox_o = fox_prompt(fq, fk, fv, logf)
    conv_ext = jnp.pad(gqkv, ((0, 0), (CONV_WIDTH - 1, 0), (0, 0)))
    q, k, v = gdn_heads(short_conv(conv_ext, conv_w))
    s_fin, gdn_o = gdn_prompt(q, k, v, g, beta)
    y = merge(fox_o, gdn_o, gg, gate_a, gate_b, norm_g, w_pa, w_pb, w_out)
    return y, (fk, fv, logf, s_fin, conv_ext[:, -(CONV_WIDTH - 1):])


def mixer_sample(h, k_cache, v_cache, logf_cache, s_cache, conv_cache,
                 w_in, forget_bias, conv_w, a_log, dt_bias, norm_g, w_pa, w_pb, w_out):
    fq, fk, fv, logf, gqkv, g, beta, gg, gate_a, gate_b = in_project(h, w_in, forget_bias, a_log, dt_bias)
    past = k_cache.shape[1]
    k_cat = jnp.concatenate([k_cache.astype(fk.dtype), fk], axis=1)
    v_cat = jnp.concatenate([v_cache.astype(fv.dtype), fv], axis=1)
    lf_cat = jnp.concatenate([logf_cache.astype(F32), logf], axis=1)
    fox_o = fox_sample(fq, k_cat, v_cat, lf_cat, past)
    conv_ext = jnp.concatenate([conv_cache.astype(gqkv.dtype), gqkv], axis=1)
    q, k, v = gdn_heads(short_conv(conv_ext, conv_w))
    s_new, gdn_o = gdn_chunk(s_cache.astype(F32), q, k, v, g, beta)
    y = merge(fox_o, gdn_o, gg, gate_a, gate_b, norm_g, w_pa, w_pb, w_out)
    return y, (fk, fv, logf, s_new, conv_ext[:, -(CONV_WIDTH - 1):])


def channel_mixer(x, pre_g, post_g, w_up, w_down):
    h = rmsnorm(x, pre_g)
    u = jnp.square(jax.nn.relu(h @ w_up))
    return x + rmsnorm(u @ w_down, post_g)


def setup_inputs(seed: int = 0) -> dict:
    key = jax.random.key(seed)
    ks = jax.random.split(key, 24)

    def nrm(k, shape, scale):
        return jax.random.normal(k, shape, F32) * scale

    def gain(k, shape):
        return 1.0 + 0.02 * jax.random.normal(k, shape, F32)

    x_prompt = nrm(ks[0], (BATCH, SEQ, D_MODEL), 1.0)
    x_sample = nrm(ks[1], (DEC_BATCH, DEC_SEQ, D_MODEL), 1.0)
    cache_fox_k = nrm(ks[2], (DEPTH, DEC_BATCH, PAST_LEN, FOX_HEADS, FOX_HEAD_DIM), 1.0)
    cache_fox_v = nrm(ks[3], (DEPTH, DEC_BATCH, PAST_LEN, FOX_HEADS, FOX_HEAD_DIM), 1.0)
    cache_fox_logf = jax.nn.log_sigmoid(
        jax.random.uniform(ks[4], (DEPTH, DEC_BATCH, PAST_LEN, FOX_HEADS), F32, 1.0, 5.0)
        + nrm(ks[5], (DEPTH, DEC_BATCH, PAST_LEN, FOX_HEADS), 1.0))
    state_gdn = nrm(ks[6], (DEPTH, DEC_BATCH, GDN_HEADS, GDN_DK, GDN_DV), 0.1)
    state_gdn_conv = nrm(ks[7], (DEPTH, DEC_BATCH, CONV_WIDTH - 1, GDN_CONV_DIM), 1.0)
    w_in = nrm(ks[8], (DEPTH, D_MODEL, IN_WIDTH), D_MODEL ** -0.5)
    fox_forget_bias = jax.random.uniform(ks[9], (DEPTH, FOX_HEADS), F32, 1.0, 5.0)
    gdn_conv_w = nrm(ks[10], (DEPTH, CONV_WIDTH, GDN_CONV_DIM), CONV_WIDTH ** -0.5)
    gdn_a_log = jnp.log(jax.random.uniform(ks[11], (DEPTH, GDN_HEADS), F32, 1.0, 16.0))
    dt = jnp.exp(jax.random.uniform(ks[12], (DEPTH, GDN_HEADS), F32, math.log(1e-3), math.log(1e-1)))
    gdn_dt_bias = dt + jnp.log(-jnp.expm1(-dt))
    gdn_norm_g = gain(ks[13], (DEPTH, GDN_DV))
    w_proj_fox = nrm(ks[14], (DEPTH, FOX_WIDTH, D_MODEL), FOX_WIDTH ** -0.5)
    w_proj_gdn = nrm(ks[15], (DEPTH, GDN_VW, D_MODEL), GDN_VW ** -0.5)
    w_out = nrm(ks[16], (DEPTH, D_MODEL, D_MODEL), D_MODEL ** -0.5)
    norm_mix_pre = gain(ks[17], (DEPTH, D_MODEL))
    norm_mix_post = gain(ks[18], (DEPTH, D_MODEL))
    norm_mlp_pre = gain(ks[19], (DEPTH, D_MODEL))
    norm_mlp_post = gain(ks[20], (DEPTH, D_MODEL))
    w_up = nrm(ks[21], (DEPTH, D_MODEL, D_FF), D_MODEL ** -0.5)
    w_down = nrm(ks[22], (DEPTH, D_FF, D_MODEL), D_FF ** -0.5)
    return {'x_prompt': x_prompt, 'x_sample': x_sample,
            'cache_fox_k': cache_fox_k, 'cache_fox_v': cache_fox_v, 'cache_fox_logf': cache_fox_logf,
            'state_gdn': state_gdn, 'state_gdn_conv': state_gdn_conv,
            'w_in': w_in, 'fox_forget_bias': fox_forget_bias, 'gdn_conv_w': gdn_conv_w,
            'gdn_a_log': gdn_a_log, 'gdn_dt_bias': gdn_dt_bias, 'gdn_norm_g': gdn_norm_g,
            'w_proj_fox': w_proj_fox, 'w_proj_gdn': w_proj_gdn, 'w_out': w_out,
            'norm_mix_pre': norm_mix_pre, 'norm_mix_post': norm_mix_post,
            'norm_mlp_pre': norm_mlp_pre, 'norm_mlp_post': norm_mlp_post,
            'w_up': w_up, 'w_down': w_down}


def reference(x_prompt, x_sample, cache_fox_k, cache_fox_v, cache_fox_logf, state_gdn, state_gdn_conv,
              w_in, fox_forget_bias, gdn_conv_w, gdn_a_log, gdn_dt_bias, gdn_norm_g,
              w_proj_fox, w_proj_gdn, w_out, norm_mix_pre, norm_mix_post, norm_mlp_pre, norm_mlp_post,
              w_up, w_down):
    y_p, y_s = x_prompt, x_sample
    st_p, st_s = [], []
    for l in range(DEPTH):
        mw = (w_in[l], fox_forget_bias[l], gdn_conv_w[l], gdn_a_log[l], gdn_dt_bias[l], gdn_norm_g[l],
              w_proj_fox[l], w_proj_gdn[l], w_out[l])
        mix, sp = mixer_prompt(rmsnorm(y_p, norm_mix_pre[l]), *mw)
        y_p = y_p + rmsnorm(mix, norm_mix_post[l])
        y_p = channel_mixer(y_p, norm_mlp_pre[l], norm_mlp_post[l], w_up[l], w_down[l])
        mix, ss = mixer_sample(rmsnorm(y_s, norm_mix_pre[l]), cache_fox_k[l], cache_fox_v[l], cache_fox_logf[l],
                               state_gdn[l], state_gdn_conv[l], *mw)
        y_s = y_s + rmsnorm(mix, norm_mix_post[l])
        y_s = channel_mixer(y_s, norm_mlp_pre[l], norm_mlp_post[l], w_up[l], w_down[l])
        st_p.append(sp)
        st_s.append(ss)
    fk_p, fv_p, lf_p, sg_p, cv_p = [jnp.stack(a) for a in zip(*st_p)]
    fk_s, fv_s, lf_s, sg_s, cv_s = [jnp.stack(a) for a in zip(*st_s)]
    return (y_p, y_s, fk_p, fv_p, lf_p, sg_p, cv_p, fk_s, fv_s, lf_s, sg_s, cv_s)
```

```cpp
#include <hip/hip_runtime.h>
#include <hip/hip_cooperative_groups.h>
#include <hip/hip_bf16.h>
#include <cstdio>
#include <cstdint>
#include <cmath>
namespace cg = cooperative_groups;
#ifndef MK_PH_MAX
#define MK_PH_MAX 11
#endif
#ifndef MK_PER_PHASE
#define MK_PER_PHASE 0
#endif
__device__ __forceinline__ int mk_tid(int wid_s) { return wid_s * 64 + (int)__builtin_amdgcn_mbcnt_hi(~0u, __builtin_amdgcn_mbcnt_lo(~0u, 0u)); }
namespace pg8 {
#define PG8_LAS __attribute__((address_space(3)))
typedef unsigned short bf16_t;
typedef short bf16x8 __attribute__((ext_vector_type(8)));
typedef float f32x4 __attribute__((ext_vector_type(4)));
typedef unsigned u32x4 __attribute__((ext_vector_type(4)));
constexpr int BM = 256, BK = 64, HALF = 128, HTB = HALF * BK * 2  , STAGE_BYTES = 8 * HTB, NXCD = 8, WGM = 8;

__host__ __device__ __forceinline__ int lds_byte(int r, int c) { const int st = (r >> 4) * 2 + (c >> 5), rr = r & 15, cc = c & 31, ob = rr * 64 + cc * 2; return st * 1024 + (ob ^ (((ob >> 9) & 1) << 5)); }
__host__ __device__ __forceinline__ void stage_rc(int b, int& R, int& C) { const int st = b / 1024, sb = b % 1024, swz = sb ^ (((sb >> 9) & 1) << 5); R = (st >> 1) * 16 + swz / 64; C = (st & 1) * 32 + (swz % 64) / 2; }
__host__ __device__ __forceinline__ int perm32(int rho) { const int n = rho >> 4, i = rho & 15; return 8 * (i >> 2) + 4 * n + (i & 3); }

struct Unit { int pm, pn; };
struct Gemm { const bf16_t* A; const bf16_t* Bt; int M, N, K, ld; };

struct StaticOrder {
    int nM, nN, nwg, G, c;
    __host__ __device__ void init(int M, int N, int G_, int c_) { nM = M / BM; nN = N / BM; nwg = nM * nN; G = G_; c = c_; }
    __host__ __device__ bool next(int i, Unit& u) const {
        const long L = (long)i * G + c; if (L >= nwg) return false;
        int wgid = (int)L; { const int q = nwg / NXCD, r = nwg % NXCD, xcd = wgid % NXCD, off = wgid / NXCD; wgid = (xcd < r ? xcd * (q + 1) : r * (q + 1) + (xcd - r) * q) + off; }
        const int nig = WGM * nN, gid = wgid / nig, fm = gid * WGM, gsz = (nM - fm) < WGM ? (nM - fm) : WGM;
        u.pm = fm + ((wgid % nig) % gsz); u.pn = (wgid % nig) / gsz; return true;
    }
    __device__ __forceinline__ void a_ready(const Unit&) const {}
    __device__ __forceinline__ void done(const Unit&) const {}
};

__device__ __forceinline__ unsigned cvt_pk_bf16(float lo, float hi) { unsigned r; asm volatile("v_cvt_pk_bf16_f32 %0, %1, %2" : "=v"(r) : "v"(lo), "v"(hi)); return r; }
template <class Epi, class Sched, bool ALIGN_EPI = false, bool SP2 = false>
__device__ __forceinline__ void gemm_phase(PG8_LAS unsigned char* lds, const Gemm g, const Sched& S, const Epi& E, const int mk_wid) {
    const int wid = mk_wid, tid = mk_tid(mk_wid), lane = tid & 63, wr = wid >> 2, wc = wid & 3, fr = lane & 15, fq = lane >> 4;
    const int K = g.K, LD = g.ld, nt = K / BK;
    unsigned voffA[2], voffB[2];
#pragma unroll
    for (int i = 0; i < 2; ++i) { int R, C; stage_rc(tid * 16 + i * 8192, R, C); const int Rb = Epi::PERM ? ((R & ~31) + perm32(R & 31)) : R;
        voffA[i] = (unsigned)(R * LD + C) * 2u; voffB[i] = (unsigned)(Rb * LD + C) * 2u; }
    const size_t kstep = (size_t)(BK * 2);
    const size_t hstep = (size_t)HALF * LD * 2;
    const size_t tstep = 2 * hstep;
    const unsigned ldsw = (unsigned)wid * 1024u;
    const int aoff = lds_byte(wr * 64 + fr, fq * 8), boff = lds_byte(wc * 32 + fr, fq * 8);
#define PG8_SA(b, h) (((b) * 2 + (h)) * HTB)
#define PG8_SB(b, h) ((4 + (b) * 2 + (h)) * HTB)
#define PG8_STAGE(bufoff, gbase, voff) do { _Pragma("unroll") for (int _i = 0; _i < 2; ++_i) \
        __builtin_amdgcn_global_load_lds((const unsigned*)((const char*)(gbase) + (voff)[_i]), (PG8_LAS unsigned*)(lds + (bufoff) + ldsw + _i * 8192), 16, 0, 0); } while (0)
#define PG8_LDA(dst, b, h) do { _Pragma("unroll") for (int m = 0; m < 4; ++m) _Pragma("unroll") for (int k = 0; k < 2; ++k) dst[m][k] = *(const PG8_LAS bf16x8*)(lds + PG8_SA(b, h) + aoff + m * 2048 + k * 1024); } while (0)
#define PG8_LDB(dst, b, h) do { _Pragma("unroll") for (int n = 0; n < 2; ++n) _Pragma("unroll") for (int k = 0; k < 2; ++k) dst[n][k] = *(const PG8_LAS bf16x8*)(lds + PG8_SB(b, h) + boff + n * 2048 + k * 1024); } while (0)
#define PG8_MMA(ai, bj, At, Bt) do { __builtin_amdgcn_s_setprio(1); _Pragma("unroll") for (int m = 0; m < 4; ++m) _Pragma("unroll") for (int n = 0; n < 2; ++n) _Pragma("unroll") for (int k = 0; k < 2; ++k) \
        acc[ai][bj][m][n] = __builtin_amdgcn_mfma_f32_16x16x32_bf16(Bt[n][k], At[m][k], acc[ai][bj][m][n], 0, 0, 0); __builtin_amdgcn_s_setprio(0); } while (0)
#define PG8_WAIT_V(n) asm volatile("s_waitcnt vmcnt(" #n ")" ::: "memory")
#define PG8_WAIT_L(n) asm volatile("s_waitcnt lgkmcnt(" #n ")" ::: "memory")
#define PG8_BAR __builtin_amdgcn_s_barrier()
#define PG8_SCHED __builtin_amdgcn_sched_barrier(0)
    Unit cur, nxt; int ui = 0;
    if (!S.next(0, cur)) return;
    f32x4 acc[2][2][4][2];
#pragma unroll
    for (int a = 0; a < 2; ++a)
#pragma unroll
        for (int b = 0; b < 2; ++b)
#pragma unroll
            for (int m = 0; m < 4; ++m)
#pragma unroll
                for (int n = 0; n < 2; ++n) acc[a][b][m][n] = (f32x4){0.f, 0.f, 0.f, 0.f};
    bf16x8 At[4][2], B0[2][2], B1[2][2];
    const char* cA = (const char*)g.A + (size_t)cur.pm * tstep; const char* cB = (const char*)g.Bt + (size_t)cur.pn * tstep;
    S.a_ready(cur);
    if constexpr (SP2) {
        PG8_STAGE(PG8_SB(0, 0), cB, voffB); PG8_STAGE(PG8_SB(0, 1), cB + hstep, voffB); PG8_STAGE(PG8_SA(0, 0), cA, voffA); PG8_STAGE(PG8_SA(0, 1), cA + hstep, voffA);
        if (wr == 1) PG8_BAR;
        PG8_WAIT_V(2); PG8_BAR;
        PG8_STAGE(PG8_SB(1, 0), cB + kstep, voffB); PG8_STAGE(PG8_SA(1, 0), cA + kstep, voffA); PG8_STAGE(PG8_SB(1, 1), cB + hstep + kstep, voffB);
        PG8_WAIT_V(6); PG8_BAR;
    } else {
        PG8_STAGE(PG8_SB(0, 0), cB, voffB); PG8_STAGE(PG8_SA(0, 0), cA, voffA); PG8_STAGE(PG8_SB(0, 1), cB + hstep, voffB); PG8_STAGE(PG8_SA(0, 1), cA + hstep, voffA);
        if (wr == 1) PG8_BAR;
        PG8_WAIT_V(4); PG8_BAR;
        PG8_STAGE(PG8_SB(1, 0), cB + kstep, voffB); PG8_STAGE(PG8_SA(1, 0), cA + kstep, voffA); PG8_STAGE(PG8_SB(1, 1), cB + hstep + kstep, voffB);
        PG8_WAIT_V(6); PG8_BAR;
    }
    for (;;) {
        const bool has_next = S.next(ui + 1, nxt);
        const char* nA = has_next ? (const char*)g.A + (size_t)nxt.pm * tstep : cA; const char* nB = has_next ? (const char*)g.Bt + (size_t)nxt.pn * tstep : cB;
        for (int t = 0; t < nt; t += 2) {
            const bool last = (t == nt - 2);
            const char* a1 = cA + (size_t)(t + 1) * kstep;
            const char* a2 = last ? nA : cA + (size_t)(t + 2) * kstep; const char* b2 = last ? nB : cB + (size_t)(t + 2) * kstep;
            const char* a3 = a2 + kstep; const char* b3 = b2 + kstep;
            if (last && has_next) S.a_ready(nxt);
            if constexpr (SP2) {
            PG8_LDB(B0, 0, 0); PG8_LDB(B1, 0, 1); PG8_SCHED; PG8_LDA(At, 0, 0); PG8_STAGE(PG8_SA(1, 1), a1 + hstep, voffA);
            PG8_WAIT_V(8); PG8_WAIT_L(0); PG8_BAR; PG8_MMA(0, 0, At, B0); PG8_MMA(0, 1, At, B1); PG8_BAR; PG8_SCHED;
            PG8_LDA(At, 0, 1); PG8_STAGE(PG8_SB(0, 0), b2, voffB); PG8_STAGE(PG8_SB(0, 1), b2 + hstep, voffB); PG8_STAGE(PG8_SA(0, 0), a2, voffA);
            PG8_WAIT_V(8); PG8_WAIT_L(0); PG8_BAR; PG8_MMA(1, 0, At, B0); PG8_MMA(1, 1, At, B1); PG8_BAR; PG8_SCHED;
            PG8_LDB(B0, 1, 0); PG8_LDB(B1, 1, 1); PG8_SCHED; PG8_LDA(At, 1, 0); PG8_STAGE(PG8_SA(0, 1), a2 + hstep, voffA);
            PG8_WAIT_V(8); PG8_WAIT_L(0); PG8_BAR; PG8_MMA(0, 0, At, B0); PG8_MMA(0, 1, At, B1); PG8_BAR; PG8_SCHED;
            PG8_LDA(At, 1, 1); PG8_STAGE(PG8_SB(1, 0), b3, voffB); PG8_STAGE(PG8_SB(1, 1), b3 + hstep, voffB); PG8_STAGE(PG8_SA(1, 0), a3, voffA);
            PG8_WAIT_V(8); PG8_WAIT_L(0); PG8_BAR; PG8_MMA(1, 0, At, B0); PG8_MMA(1, 1, At, B1); PG8_BAR; PG8_SCHED;
            } else {
            PG8_LDB(B0, 0, 0); PG8_SCHED; PG8_LDA(At, 0, 0); PG8_STAGE(PG8_SA(1, 1), a1 + hstep, voffA);
            PG8_WAIT_L(8); PG8_BAR; PG8_WAIT_L(0); PG8_MMA(0, 0, At, B0); PG8_BAR; PG8_SCHED;
            PG8_LDB(B1, 0, 1); PG8_STAGE(PG8_SB(0, 0), b2, voffB);
            PG8_BAR; PG8_WAIT_L(0); PG8_MMA(0, 1, At, B1); PG8_BAR;
            PG8_LDA(At, 0, 1); PG8_STAGE(PG8_SA(0, 0), a2, voffA);
            PG8_BAR; PG8_WAIT_L(0); PG8_MMA(1, 0, At, B0); PG8_BAR; PG8_SCHED;
            PG8_STAGE(PG8_SB(0, 1), b2 + hstep, voffB);
            PG8_WAIT_V(6); PG8_BAR; PG8_MMA(1, 1, At, B1); PG8_BAR;
            PG8_LDB(B0, 1, 0); PG8_SCHED; PG8_LDA(At, 1, 0); PG8_STAGE(PG8_SA(0, 1), a2 + hstep, voffA);
            PG8_WAIT_L(8); PG8_BAR; PG8_WAIT_L(0); PG8_MMA(0, 0, At, B0); PG8_BAR; PG8_SCHED;
            PG8_LDB(B1, 1, 1); PG8_STAGE(PG8_SB(1, 0), b3, voffB);
            PG8_BAR; PG8_WAIT_L(0); PG8_MMA(0, 1, At, B1); PG8_BAR;
            PG8_LDA(At, 1, 1); PG8_STAGE(PG8_SA(1, 0), a3, voffA);
            PG8_BAR; PG8_WAIT_L(0); PG8_MMA(1, 0, At, B0); PG8_BAR; PG8_SCHED;
            PG8_STAGE(PG8_SB(1, 1), b3 + hstep, voffB);
            PG8_WAIT_V(6); PG8_BAR; PG8_MMA(1, 1, At, B1); PG8_BAR;
            }
        }
        if constexpr (ALIGN_EPI) { if (wr == 0) PG8_BAR; }
        if constexpr (!Epi::AFTER_DRAIN) { E(acc, cur, wr, wc, fr, fq); S.done(cur); }
        if (!has_next) break;
#pragma unroll
        for (int a = 0; a < 2; ++a)
#pragma unroll
            for (int b = 0; b < 2; ++b)
#pragma unroll
                for (int m = 0; m < 4; ++m)
#pragma unroll
                    for (int n = 0; n < 2; ++n) acc[a][b][m][n] = (f32x4){0.f, 0.f, 0.f, 0.f};
        cur = nxt; cA = nA; cB = nB; ++ui;
        if constexpr (ALIGN_EPI) { if (wr == 1) PG8_BAR; }
    }
    PG8_WAIT_V(0);
    if constexpr (!ALIGN_EPI) { if (wr == 0) PG8_BAR; }
    PG8_BAR;
    if constexpr (Epi::AFTER_DRAIN) { E.fused(acc, cur, wr, wc, fr, fq, lds, wid, lane); S.done(cur); }
#undef PG8_SA
#undef PG8_SB
#undef PG8_STAGE
#undef PG8_LDA
#undef PG8_LDB
#undef PG8_MMA
#undef PG8_WAIT_V
#undef PG8_WAIT_L
#undef PG8_BAR
#undef PG8_SCHED
}
}
namespace attn_body {
using bf16=__hip_bfloat16;
using bf16x8=__attribute__((ext_vector_type(8)))short;
using s16x4=__attribute__((ext_vector_type(4)))short;
using f32x16=__attribute__((ext_vector_type(16)))float;
using u32x4=__attribute__((ext_vector_type(4)))unsigned;
constexpr int NHEAD=8,D=64,DM=NHEAD*D;
constexpr int NW=8,QBLK=32,QB=QBLK*NW,KVBLK=64;
constexpr int ATTN_PITCH=DM, ATTN_UNIT_ROWS=QB;
__device__ __forceinline__ int crow(int r,int hi){return (r&3)+8*(r>>2)+4*hi;}
#define SBAR() __builtin_amdgcn_sched_barrier(0)
__device__ __forceinline__ void cmask(f32x16&p0,f32x16&p1,int jb,int qrel,int hi){
  const float NEG=-INFINITY; int kb=64*jb+4*hi;
  #pragma unroll
  for(int r=0;r<16;++r){int kv=kb+(r&3)+8*(r>>2); if(kv>qrel)p0[r]=NEG; if(kv+32>qrel)p1[r]=NEG;}
}

constexpr int NSLOT=3, SLOTB=8192;
constexpr int LDS_K=0, LDS_V=NSLOT*SLOTB, LDS_WS=2*NSLOT*SLOTB, LDS_OST=LDS_WS+NW*64*4, LDS_BYTES=LDS_OST+NW*4096;
constexpr float C2=0.125f*1.4426950408889634f;
__device__ __forceinline__ void glds16(const void*gsrc,unsigned lds_dst){unsigned keep;
  asm volatile("s_mov_b32 %0, m0\n\ts_mov_b32 m0, %2\n\ts_nop 0\n\tglobal_load_lds_dwordx4 %1, off\n\ts_mov_b32 m0, %0":"=&s"(keep):"v"(gsrc),"s"(lds_dst):"memory");}
__device__ __forceinline__ void glds16s(const void*sbase,unsigned voff,unsigned lds_dst){unsigned keep;
  asm volatile("s_mov_b32 %0, m0\n\ts_mov_b32 m0, %3\n\ts_nop 0\n\tglobal_load_lds_dwordx4 %1, %2\n\ts_mov_b32 m0, %0":"=&s"(keep):"v"(voff),"s"(sbase),"s"(lds_dst):"memory");}
__device__ __forceinline__ float max3f(float a,float b,float c){float r;asm("v_max3_f32 %0, %1, %2, %3":"=v"(r):"v"(a),"v"(b),"v"(c));return r;}
__device__ __forceinline__ float max2f(float a,float b){float r;asm("v_max_f32_e32 %0, %1, %2":"=v"(r):"v"(a),"v"(b));return r;}
__device__ __forceinline__ float fadd_s(float a,float b){float r;asm("v_add_f32_e32 %0, %1, %2":"=v"(r):"v"(a),"v"(b));return r;}
__device__ __forceinline__ float fsub_s(float a,float b){float r;asm("v_sub_f32_e32 %0, %1, %2":"=v"(r):"v"(a),"v"(b));return r;}
typedef float f32x2_t __attribute__((ext_vector_type(2))); typedef __bf16 bf16x2_t __attribute__((ext_vector_type(2)));
__device__ __forceinline__ unsigned cvtpk_s(float lo,float hi){f32x2_t v={lo,hi};bf16x2_t b=__builtin_convertvector(v,bf16x2_t);return __builtin_bit_cast(unsigned,b);}
#define WAIT_BAR(N) asm volatile("s_waitcnt vmcnt(" #N ") lgkmcnt(0)\n\ts_barrier":::"memory")

__device__ __forceinline__ void qkt(f32x16&p0,f32x16&p1,const char*Kslot,const bf16x8*qr,const f32x16&i0,const f32x16&i1,int r32,int hi){
  const char*kb=Kslot+hi*1024+r32*16;
  #pragma unroll
  for(int d0=0;d0<4;++d0){
    const bf16x8 b0=*reinterpret_cast<const bf16x8*>(kb+d0*2048);
    const bf16x8 b1=*reinterpret_cast<const bf16x8*>(kb+d0*2048+512);
    if(d0==0){p0=__builtin_amdgcn_mfma_f32_32x32x16_bf16(b0,qr[0],i0,0,0,0);p1=__builtin_amdgcn_mfma_f32_32x32x16_bf16(b1,qr[0],i1,0,0,0);}
    else{p0=__builtin_amdgcn_mfma_f32_32x32x16_bf16(b0,qr[d0],p0,0,0,0);p1=__builtin_amdgcn_mfma_f32_32x32x16_bf16(b1,qr[d0],p1,0,0,0);}}
}
typedef __attribute__((address_space(3))) const char* lds_cptr;
typedef short v4i16_t __attribute__((ext_vector_type(4)));
__device__ __forceinline__ void kload8(bf16x8*kf,lds_cptr kp){
  kf[0]=*(const __attribute__((address_space(3))) bf16x8*)(kp);      kf[1]=*(const __attribute__((address_space(3))) bf16x8*)(kp+512);
  kf[2]=*(const __attribute__((address_space(3))) bf16x8*)(kp+2048); kf[3]=*(const __attribute__((address_space(3))) bf16x8*)(kp+2560);
  kf[4]=*(const __attribute__((address_space(3))) bf16x8*)(kp+4096); kf[5]=*(const __attribute__((address_space(3))) bf16x8*)(kp+4608);
  kf[6]=*(const __attribute__((address_space(3))) bf16x8*)(kp+6144); kf[7]=*(const __attribute__((address_space(3))) bf16x8*)(kp+6656);
}
__device__ __forceinline__ void kload2(bf16x8*kf,lds_cptr kp,int j){ kf[2*j]=*(const __attribute__((address_space(3))) bf16x8*)(kp+j*2048); kf[2*j+1]=*(const __attribute__((address_space(3))) bf16x8*)(kp+j*2048+512); }
__device__ __forceinline__ s16x4 vtr(lds_cptr p){ return __builtin_bit_cast(s16x4,__builtin_amdgcn_ds_read_tr16_b64_v4i16((__attribute__((address_space(3))) v4i16_t*)p)); }
__device__ __forceinline__ float rowmax(const f32x16&p0,const f32x16&p1){
  float a=max3f(p0[0],p0[1],p1[0]),b=max3f(p0[2],p0[3],p1[1]);a=max3f(a,p1[2],p1[3]);
  #pragma unroll
  for(int r=4;r<16;r+=4){a=max3f(a,p0[r],p0[r+1]);b=max3f(b,p0[r+2],p0[r+3]);a=max3f(a,p1[r],p1[r+1]);b=max3f(b,p1[r+2],p1[r+3]);}
  const float m=max2f(a,b);
  auto rr=__builtin_amdgcn_permlane32_swap(__float_as_uint(m),__float_as_uint(m),false,false);
  return max2f(__uint_as_float(rr[0]),__uint_as_float(rr[1]));
}
__device__ __forceinline__ void pv(f32x16*o,int vb,bf16x8 pa0,bf16x8 pa1,bf16x8 pa2,bf16x8 pa3){
  #pragma unroll
  for(int d0=0;d0<2;++d0){s16x4 lo[4],hi[4];
    #pragma unroll
    for(int ks=0;ks<4;++ks){
      asm volatile("ds_read_b64_tr_b16 %0,%1 offset:%c2":"=&v"(lo[ks]):"v"(vb),"i"(d0*4096+ks*1024):"memory");
      asm volatile("ds_read_b64_tr_b16 %0,%1 offset:%c2":"=&v"(hi[ks]):"v"(vb),"i"(d0*4096+ks*1024+512):"memory");}
    asm volatile("s_waitcnt lgkmcnt(0)":::"memory");SBAR();
    #define PK(k) (bf16x8){lo[k][0],lo[k][1],lo[k][2],lo[k][3],hi[k][0],hi[k][1],hi[k][2],hi[k][3]}
    o[d0]=__builtin_amdgcn_mfma_f32_32x32x16_bf16(pa0,PK(0),o[d0],0,0,0);
    o[d0]=__builtin_amdgcn_mfma_f32_32x32x16_bf16(pa1,PK(1),o[d0],0,0,0);
    o[d0]=__builtin_amdgcn_mfma_f32_32x32x16_bf16(pa2,PK(2),o[d0],0,0,0);
    o[d0]=__builtin_amdgcn_mfma_f32_32x32x16_bf16(pa3,PK(3),o[d0],0,0,0);
    #undef PK
  }
}

#ifndef ATTN_STORE16
#define ATTN_STORE16(p,v) (*(u32x4*)(p)=(v))
#endif
template<int THRL> __device__ __forceinline__ void attn_unit(int q0,int nvalid,const bf16*Qu,const bf16*__restrict__ Kh,const bf16*__restrict__ Vh,bf16*Ou,const float*__restrict__ G,char*shm,const int mk_wid){
  const int wid=mk_wid,tid=mk_tid(mk_wid),lane=tid&63,r32=lane&31,hi=lane>>5;
  const bf16*Qw=Qu+(long)(wid*QBLK)*DM;
  const unsigned lds0=(unsigned)(uintptr_t)shm;
  float*wsf=(float*)(shm+LDS_WS)+wid*64;
  const unsigned kvoff=(unsigned)((lane*DM+wid*8)*2);
  const unsigned vvoff=(unsigned)(((16*(wid&3)+(lane>>2))*DM+(wid>>2)*32+(lane&3)*8)*2);
  const unsigned kdst=lds0+LDS_K+wid*1024, vdst=lds0+LDS_V+wid*1024;
  #define DMA_K(t,slot) glds16s(Kh+(long)(t)*KVBLK*DM,kvoff,(unsigned)__builtin_amdgcn_readfirstlane(kdst+(slot)))
  #define DMA_V(t,slot) glds16s(Vh+(long)(t)*KVBLK*DM,vvoff,(unsigned)__builtin_amdgcn_readfirstlane(vdst+(slot)))
  const int vb0=(int)(lds0+LDS_V)+((lane>>4)&1)*32+(lane&3)*8+(4*hi+((lane&15)>>2))*64;
  const char*Kbase=shm+LDS_K; bf16x8 kf[8];
  const lds_cptr shm3=(lds_cptr)shm; const lds_cptr kp0=shm3+LDS_K+hi*1024+r32*16; const lds_cptr vp0=shm3+LDS_V+((lane>>4)&1)*32+(lane&3)*8+(4*hi+((lane&15)>>2))*64;
  { float*fbw=(float*)(shm+LDS_OST); const float gref=G[q0]; for(int j=tid;j<q0+QB;j+=512) fbw[j]=(gref-G[j])*1.4426950408889634f; }
  const __attribute__((address_space(3))) float* fbl=(const __attribute__((address_space(3))) float*)(shm3+LDS_OST)+r32;
  #define BIASMF(t,w,bq) __builtin_amdgcn_mfma_f32_32x32x2f32((hi?1.0f:fbl[64*(t)+32*(w)]),(bq),negm,0,0,0)
  const int NT=(q0+QB)/KVBLK;
  DMA_K(0,0);DMA_V(0,0);DMA_K(1,SLOTB);
  bf16x8 qr[4];
  #pragma unroll
  for(int d0=0;d0<4;++d0)qr[d0]=*reinterpret_cast<const bf16x8*>(&Qw[(long)r32*DM+d0*16+hi*8]);
  float mhat=0.f,l_reg=0.f;f32x16 o[2];o[0]=f32x16{};o[1]=f32x16{};const f32x16 negm=f32x16{};
  const int qrel=wid*QBLK+r32;
  #define CMASK(P0,P1,t) do{int jb_=(t)-(NT-4); if(jb_>=0)cmask(P0,P1,jb_,qrel,hi);}while(0)
  bool resc=false;
  #define START(P0,P1) do{ const float rm=rowmax(P0,P1); resc=false; \
    { const float dl=rm; mhat=fadd_s(mhat,dl); \
      _Pragma("unroll") for(int r=0;r<16;++r){P0[r]=fsub_s(P0[r],dl);P1[r]=fsub_s(P1[r],dl);} \
      } \
    _Pragma("unroll") for(int r=0;r<16;++r)P0[r]=__builtin_amdgcn_exp2f(P0[r]); }while(0)
  #define RESC() do{ if(resc){ asm volatile("s_waitcnt lgkmcnt(0)":::"memory"); \
      _Pragma("unroll") for(int d_=0;d_<2;++d_) _Pragma("unroll") for(int r=0;r<16;++r)o[d_][r]*=wsf[crow(r,hi)]; } }while(0)
  f32x16 pA0,pA1,pB0,pB1;
  int sl_prev=0,sl_cur=0,sl_next=SLOTB;
  #define ROT() do{sl_prev=sl_cur;sl_cur=sl_next;sl_next=(sl_next==(NSLOT-1)*SLOTB)?0:sl_next+SLOTB;}while(0)
  DMA_K(2,2*SLOTB);
  WAIT_BAR(3);
  { const float bq0_=hi?0.f:1.f; qkt(pA0,pA1,Kbase,qr,BIASMF(0,0,bq0_),BIASMF(0,1,bq0_),r32,hi); }asm volatile("s_nop 15\n\ts_nop 7":"+v"(pA0),"+v"(pA1));CMASK(pA0,pA1,0);
  START(pA0,pA1);
  _Pragma("unroll") for(int r=0;r<16;++r)pA1[r]=__builtin_amdgcn_exp2f(pA1[r]);
  WAIT_BAR(0);
  DMA_K(3,0);DMA_V(1,SLOTB);
  ROT();
  kload8(kf,kp0+sl_cur);
  WAIT_BAR(2);
  s16x4 vlo[8],vhi[8]; u32x4 pw0,pw1,pw2,pw3;
  #define PKW(P,B) cvtpk_s(P[B],P[B+1])
  #define PAF(k) __builtin_bit_cast(bf16x8,pw##k)
  #define VFR(i) (bf16x8){vlo[i][0],vlo[i][1],vlo[i][2],vlo[i][3],vhi[i][0],vhi[i][1],vhi[i][2],vhi[i][3]}
  #define PIN(x) asm volatile("":"+v"(x))
  #define MX3(a,b,c) __builtin_fmaxf(__builtin_fmaxf((a),(b)),(c))
  #define GAPA(MF,A0,A1,A2,A3,W0,W1,PW) do{ MF; sacc+=A0; sacc+=A1; sacc+=A2; sacc+=A3; PIN(sacc); W0; W1; PIN(PW); SBAR(); }while(0)
  #define EX(v) __builtin_amdgcn_exp2f(v)
  #define GAPB(MF,X,B) do{ MF; X[B]=EX(X[B]); X[B+1]=EX(X[B+1]); X[B+2]=EX(X[B+2]); X[B+3]=EX(X[B+3]); PIN(X); SBAR(); }while(0)
  #define VRD(i) do{ vlo[i]=vtr(vp_+(((i)>>2)*4096+((i)&3)*1024)); vhi[i]=vtr(vp_+(((i)>>2)*4096+((i)&3)*1024+512)); }while(0)
  #define KRD(G,j) do{ if(G){ kload2(kf,kp0+sl_next,j); SBAR(); } }while(0)
  #define STEP(C0,C1,P0,P1,t,GK,GV,GL) do{ SBAR(); \
    const lds_cptr vp_=vp0+sl_prev; \
    const float bq_=hi?-mhat:1.0f; float ba0_=fbl[64*(t)], ba1_=fbl[64*(t)+32]; asm volatile("":"+v"(ba0_),"+v"(ba1_)); SBAR(); VRD(0); SBAR(); float sacc=(P0[0]+P0[1]); \
    GAPA(C0=__builtin_amdgcn_mfma_f32_32x32x16_bf16(kf[0],qr[0],__builtin_amdgcn_mfma_f32_32x32x2f32((hi?1.0f:ba0_),bq_,negm,0,0,0),0,0,0), P0[2],P0[3],P0[4],P0[5],     pw0[0]=PKW(P0,0), pw0[1]=PKW(P0,2), pw0); \
    VRD(4); SBAR(); GAPA(C1=__builtin_amdgcn_mfma_f32_32x32x16_bf16(kf[1],qr[0],__builtin_amdgcn_mfma_f32_32x32x2f32((hi?1.0f:ba1_),bq_,negm,0,0,0),0,0,0), P0[6],P0[7],P0[8],P0[9],     pw0[2]=PKW(P0,4), pw0[3]=PKW(P0,6), pw0); \
    VRD(1); SBAR(); GAPA(C0=__builtin_amdgcn_mfma_f32_32x32x16_bf16(kf[2],qr[1],C0,0,0,0),   P0[10],P0[11],P0[12],P0[13], pw1[0]=PKW(P0,8), pw1[1]=PKW(P0,10), pw1); \
    VRD(5); SBAR(); GAPA(C1=__builtin_amdgcn_mfma_f32_32x32x16_bf16(kf[3],qr[1],C1,0,0,0),   P0[14],P0[15],P1[0],P1[1],   pw1[2]=PKW(P0,12),pw1[3]=PKW(P0,14), pw1); \
    VRD(2); SBAR(); GAPA(C0=__builtin_amdgcn_mfma_f32_32x32x16_bf16(kf[4],qr[2],C0,0,0,0),   P1[2],P1[3],P1[4],P1[5],     pw2[0]=PKW(P1,0), pw2[1]=PKW(P1,2), pw2); \
    VRD(6); SBAR(); GAPA(C1=__builtin_amdgcn_mfma_f32_32x32x16_bf16(kf[5],qr[2],C1,0,0,0),   P1[6],P1[7],P1[8],P1[9],     pw2[2]=PKW(P1,4), pw2[3]=PKW(P1,6), pw2); \
    VRD(3); SBAR(); GAPA(C0=__builtin_amdgcn_mfma_f32_32x32x16_bf16(kf[6],qr[3],C0,0,0,0),   P1[10],P1[11],P1[12],P1[13], pw3[0]=PKW(P1,8), pw3[1]=PKW(P1,10), pw3); \
    VRD(7); SBAR(); GAPA(C1=__builtin_amdgcn_mfma_f32_32x32x16_bf16(kf[7],qr[3],C1,0,0,0),   P1[14],P1[15],0.f,0.f,       pw3[2]=PKW(P1,12),pw3[3]=PKW(P1,14), pw3); \
    l_reg+=sacc; \
    if(GK){DMA_K((t)+3,sl_cur);} if(GV){DMA_V((t)+1,sl_next);} \
    CMASK(C0,C1,t); \
    { float a=MX3(C0[0],C0[1],C1[0]),b=MX3(C0[2],C0[3],C1[1]); a=MX3(a,C1[2],C1[3]); \
      _Pragma("unroll") for(int r=4;r<16;r+=4){a=MX3(a,C0[r],C0[r+1]);b=MX3(b,C0[r+2],C0[r+3]);a=MX3(a,C1[r],C1[r+1]);b=MX3(b,C1[r+2],C1[r+3]);} \
      float rm=__builtin_fmaxf(a,b); { auto rr=__builtin_amdgcn_permlane32_swap(__float_as_uint(rm),__float_as_uint(rm),false,false); rm=__builtin_fmaxf(__uint_as_float(rr[0]),__uint_as_float(rr[1])); } \
      resc=false; \
      if(__builtin_expect(__any(rm>(float)THRL),0)){ const float dl=__builtin_fmaxf(rm,0.f); mhat+=dl; \
        _Pragma("unroll") for(int r=0;r<16;++r){C0[r]-=dl;C1[r]-=dl;} \
        const float f=__builtin_amdgcn_exp2f(-dl); l_reg*=f; if(hi==0)wsf[r32]=f; resc=true; } } \
    SBAR(); \
    GAPB(o[0]=__builtin_amdgcn_mfma_f32_32x32x16_bf16(PAF(0),VFR(0),o[0],0,0,0), C0,0); \
    GAPB(o[1]=__builtin_amdgcn_mfma_f32_32x32x16_bf16(PAF(0),VFR(4),o[1],0,0,0), C0,4); \
    KRD(GL,0); GAPB(o[0]=__builtin_amdgcn_mfma_f32_32x32x16_bf16(PAF(1),VFR(1),o[0],0,0,0), C0,8); \
    KRD(GL,1); GAPB(o[1]=__builtin_amdgcn_mfma_f32_32x32x16_bf16(PAF(1),VFR(5),o[1],0,0,0), C0,12); \
    KRD(GL,2); GAPB(o[0]=__builtin_amdgcn_mfma_f32_32x32x16_bf16(PAF(2),VFR(2),o[0],0,0,0), C1,0); \
    KRD(GL,3); GAPB(o[1]=__builtin_amdgcn_mfma_f32_32x32x16_bf16(PAF(2),VFR(6),o[1],0,0,0), C1,4); \
    GAPB(o[0]=__builtin_amdgcn_mfma_f32_32x32x16_bf16(PAF(3),VFR(3),o[0],0,0,0), C1,8); \
    GAPB(o[1]=__builtin_amdgcn_mfma_f32_32x32x16_bf16(PAF(3),VFR(7),o[1],0,0,0), C1,12); \
    }while(0)
  int t=1;
  #undef CMASK
  #define CMASK(P0,P1,t) do{}while(0)
  for(;t+5<NT;t+=2){
    STEP(pB0,pB1,pA0,pA1,t,true,true,true);     WAIT_BAR(2); RESC(); ROT();
    STEP(pA0,pA1,pB0,pB1,t+1,true,true,true);   WAIT_BAR(2); RESC(); ROT();
  }
  #undef CMASK
  #define CMASK(P0,P1,t) do{int jb_=(t)-(NT-4); if(jb_>=0)cmask(P0,P1,jb_,qrel,hi);}while(0)
  #define ENDW(tt) do{ if((tt)+3<NT){WAIT_BAR(2);} else if((tt)+2<NT){WAIT_BAR(1);} else {WAIT_BAR(0);} }while(0)
  for(;t+1<NT;t+=2){
    STEP(pB0,pB1,pA0,pA1,t,(t+3<NT),(t+1<NT),(t+1<NT));       ENDW(t);   RESC(); ROT();
    STEP(pA0,pA1,pB0,pB1,t+1,(t+4<NT),(t+2<NT),(t+2<NT));     ENDW(t+1); RESC(); ROT();
  }
  STEP(pB0,pB1,pA0,pA1,NT-1,false,false,false); RESC();
  { float sacc=pB0[0]+pB0[1]; _Pragma("unroll") for(int r=2;r<16;++r)sacc+=pB0[r]; _Pragma("unroll") for(int r=0;r<16;++r)sacc+=pB1[r]; l_reg+=sacc;
    pw0=(u32x4){PKW(pB0,0),PKW(pB0,2),PKW(pB0,4),PKW(pB0,6)};pw1=(u32x4){PKW(pB0,8),PKW(pB0,10),PKW(pB0,12),PKW(pB0,14)};pw2=(u32x4){PKW(pB1,0),PKW(pB1,2),PKW(pB1,4),PKW(pB1,6)};pw3=(u32x4){PKW(pB1,8),PKW(pB1,10),PKW(pB1,12),PKW(pB1,14)};
    SBAR(); pv(o,vb0+sl_cur,PAF(0),PAF(1),PAF(2),PAF(3)); }
  #undef PKW
  #undef PAF
  #undef VFR
  #undef PIN
  #undef MX3
  #undef GAPA
  #undef GAPB
  #undef EX
  #undef VRD
  #undef KRD
  #undef STEP
  #undef ENDW
  {auto rr=__builtin_amdgcn_permlane32_swap(__float_as_uint(l_reg),__float_as_uint(l_reg),false,false);l_reg=__uint_as_float(rr[0])+__uint_as_float(rr[1]);}
  if(hi==0)wsf[32+r32]=l_reg;asm volatile("s_waitcnt lgkmcnt(0)":::"memory");
  float rli[16];
  #pragma unroll
  for(int r=0;r<16;++r)rli[r]=__builtin_amdgcn_rcpf(wsf[32+crow(r,hi)]);
  bf16*Ow=Ou+(long)(wid*QBLK)*DM;
  asm volatile("s_waitcnt lgkmcnt(0)\n\ts_barrier":::"memory");
  { bf16*stg=(bf16*)(shm+LDS_OST)+wid*2048;
    #pragma unroll
    for(int r=0;r<16;++r){const int orow=crow(r,hi);
      #pragma unroll
      for(int d0=0;d0<2;++d0)stg[orow*64+d0*32+r32]=__float2bfloat16(o[d0][r]*rli[r]);}
    asm volatile("s_waitcnt lgkmcnt(0)":::"memory");
    #pragma unroll
    for(int i=0;i<4;++i){const int row=i*8+(lane>>3),ch=lane&7; const u32x4 v=*(const u32x4*)(stg+row*64+ch*8); if(wid*QBLK+row<nvalid)ATTN_STORE16(Ow+(long)row*DM+ch*8,v);} }
  asm volatile("s_waitcnt lgkmcnt(0)\n\ts_barrier":::"memory");
  #undef BIASMF
  #undef DMA_K
  #undef DMA_V
  #undef CMASK
  #undef START
  #undef RESC
  #undef ROT
}
constexpr int ATTN_LDS_BYTES=LDS_BYTES;
#undef SBAR
#undef WAIT_BAR
}

namespace mk {
#define LAS __attribute__((address_space(3)))
typedef unsigned short bf16_t;
typedef short bf16x8 __attribute__((ext_vector_type(8)));
typedef float f32x4 __attribute__((ext_vector_type(4)));
typedef unsigned u32x4 __attribute__((ext_vector_type(4)));
typedef unsigned u32x2 __attribute__((ext_vector_type(2)));

constexpr int DMODEL = 1024, NPROMPT = 32768, NSAMP = 256, MROWS = 33024, SEQ = 8192, NZ = 5888, DFF = 4096;
constexpr int SKV = 2304, PAST = 2048, NCHUNK = 4224;
constexpr float EPS = 1e-6f;
constexpr size_t MiB = (size_t)1 << 20;
constexpr size_t WS_WIN = 0, WS_WPA = 12 * MiB, WS_WPB = 13 * MiB, WS_WOUT = 14 * MiB, WS_WUP = 16 * MiB, WS_WDN = 24 * MiB;
constexpr size_t WS_CTL = 32 * MiB;
constexpr size_t CTL_BYTES = 4096;
constexpr size_t WS_RS1 = 106 * MiB, WS_RS2 = 170 * MiB;
constexpr size_t WS_BAR = 32 * MiB + 512 * 1024;
constexpr size_t WS_GB = 33 * MiB;
constexpr size_t WS_GCP = 36 * MiB, WS_GCS = 37 * MiB;
constexpr size_t WS_QP = 40 * MiB;
constexpr size_t WS_KP = 73 * MiB, WS_VP = 105 * MiB;
constexpr size_t WS_QS = 137 * MiB;
constexpr size_t WS_KS = 141 * MiB, WS_VS = 177 * MiB;
constexpr size_t WS_ZC = 213 * MiB;
constexpr size_t WS_GG = 310 * MiB;
constexpr size_t WS_QG = 343 * MiB, WS_KG = 376 * MiB, WS_KTG = 409 * MiB, WS_WG = 442 * MiB, WS_UTG = 475 * MiB, WS_GCG = 508 * MiB;
constexpr size_t WS_XN = 447 * MiB + MiB / 2;
constexpr size_t WS_VNT = 213 * MiB, WS_ST = 246 * MiB;
constexpr size_t WS_OG = 73 * MiB;
constexpr size_t WS_TMP = 141 * MiB, WS_MB = 213 * MiB, WS_MIX = 343 * MiB, WS_XN2 = 141 * MiB, WS_H = 213 * MiB, WS_DOWN = 40 * MiB;
constexpr size_t WS_DOWNP = 206 * MiB;
constexpr size_t WS_END = 512 * MiB;
constexpr size_t O_Y = 0, O_FKP = 33816576, O_FVP = 50593792, O_LFP = 67371008, O_SGP = 67633152, O_CVP = 67764224,
                 O_FKS = 67782656, O_FVS = 67913728, O_LFS = 68044800, O_SGS = 68046848, O_CVS = 68571136, O_END = 68644864;
constexpr int LDS_BYTES = 147456;
constexpr float C2 = 0.125f * 1.4426950408889634f;

struct Params { const float* in[22]; float* out; unsigned char* ws; int ph_lo, ph_hi; };
typedef const __attribute__((address_space(4))) Params* KP;

typedef float f32x2_t __attribute__((ext_vector_type(2))); typedef __bf16 bf16x2_t __attribute__((ext_vector_type(2)));
__device__ __forceinline__ unsigned cvtpk(float lo, float hi) { const f32x2_t v = {lo, hi}; const bf16x2_t b = __builtin_convertvector(v, bf16x2_t); return __builtin_bit_cast(unsigned, b); }
__device__ __forceinline__ float bflo(unsigned u) { return __uint_as_float(u << 16); }
__device__ __forceinline__ float bfhi(unsigned u) { return __uint_as_float(u & 0xffff0000u); }
__device__ __forceinline__ float bf2f(bf16_t h) { return __uint_as_float((unsigned)h << 16); }
__device__ __forceinline__ float sigmoidf_(float x) { return 1.0f / (1.0f + __expf(-x)); }
__device__ __forceinline__ float softplusf_(float x) { return fmaxf(x, 0.f) + log1pf(__expf(-fabsf(x))); }
__device__ __forceinline__ float wave_sum(float v) {
#pragma unroll
    for (int o = 32; o > 0; o >>= 1) v += __shfl_xor(v, o);
    return v;
}
__device__ __forceinline__ u32x4 pack8(const f32x4& a, const f32x4& b) { u32x4 w; w.x = cvtpk(a[0], a[1]); w.y = cvtpk(a[2], a[3]); w.z = cvtpk(b[0], b[1]); w.w = cvtpk(b[2], b[3]); return w; }
__device__ __forceinline__ bf16x8 ld2x8(const bf16_t* p0, const bf16_t* p1) { const u32x2 a = *(const u32x2*)p0, b = *(const u32x2*)p1; const u32x4 v = {a.x, a.y, b.x, b.y}; return __builtin_bit_cast(bf16x8, v); }
#define MFMA16(a, b, c) __builtin_amdgcn_mfma_f32_16x16x32_bf16((a), (b), (c), 0, 0, 0)

using pg8::Unit;
struct EpiIn {
    static constexpr bool PERM = true, AFTER_DRAIN = false;
    float* out; unsigned char* ws; const float* fbias; const float* alog; const float* dtb;
    __device__ __forceinline__ void emit(int pn, int row, int cl, f32x4 v0, f32x4 v1) const {
        const bool samp = row >= NPROMPT; const int sr = row - NPROMPT;
        const int c = pn * 256 + cl;
        if (pn < 2) {
            bf16_t* dst = samp ? (bf16_t*)(ws + WS_QS) + ((size_t)((sr >> 4) * 256 + (sr & 15)) * 512 + c) : (bf16_t*)(ws + WS_QP) + ((size_t)row * 512 + c);
            *(u32x4*)dst = pack8(v0 * C2, v1 * C2);
        } else if (pn < 6) {
            const bool isv = pn >= 4; const int cc = c - (isv ? 1024 : 512);
            float* fo = out + (samp ? (isv ? O_FVS : O_FKS) + (size_t)sr * 512 : (isv ? O_FVP : O_FKP) + (size_t)row * 512) + cc;
            __builtin_nontemporal_store(v0, (f32x4*)fo); __builtin_nontemporal_store(v1, (f32x4*)(fo + 4));
            bf16_t* dst = samp ? (bf16_t*)(ws + (isv ? WS_VS : WS_KS)) + ((size_t)((sr >> 4) * SKV + PAST + (sr & 15)) * 512 + cc)
                               : (bf16_t*)(ws + (isv ? WS_VP : WS_KP)) + ((size_t)row * 512 + cc);
            *(u32x4*)dst = pack8(v0, v1);
        } else if (pn < 12) {
            const int cc = c - 1536;
            *(u32x4*)((bf16_t*)(ws + WS_ZC) + ((size_t)row * 1536 + cc)) = pack8(v0, v1);
            if (samp) { const int t = sr & 15; if (t >= 13) { float* fo = out + O_CVS + (size_t)((sr >> 4) * 3 + t - 13) * 1536 + cc; *(f32x4*)fo = v0; *(f32x4*)(fo + 4) = v1; } }
            else { const int t = row & 8191; if (t >= 8189) { float* fo = out + O_CVP + (size_t)((row >> 13) * 3 + t - 8189) * 1536 + cc; *(f32x4*)fo = v0; *(f32x4*)(fo + 4) = v1; } }
        } else if (pn < 14) {
            const int cc = c - 3072;
            *(u32x4*)((bf16_t*)(ws + WS_GG) + ((size_t)row * 512 + cc)) = pack8(v0, v1);
        } else if (pn < 22) {
            const int cc = c - 3584; f32x4 s0, s1;
#pragma unroll
            for (int e = 0; e < 4; ++e) { s0[e] = sigmoidf_(v0[e]); s1[e] = sigmoidf_(v1[e]); }
            *(u32x4*)((bf16_t*)out + ((size_t)row * 2048 + cc)) = pack8(s0, s1);
        } else {
            const int cc = c - 5632;
            if (cc == 0) { f32x4 a, b;
#pragma unroll
                for (int e = 0; e < 4; ++e) { a[e] = -softplusf_(-(v0[e] + fbias[e])); b[e] = -softplusf_(-(v1[e] + fbias[4 + e])); }
                float* fo = out + (samp ? O_LFS + (size_t)sr * 8 : O_LFP + (size_t)row * 8); *(f32x4*)fo = a; *(f32x4*)(fo + 4) = b;
            } else if (cc == 8) { f32x4 a, b;
#pragma unroll
                for (int e = 0; e < 4; ++e) { a[e] = -__expf(alog[e]) * softplusf_(v0[e] + dtb[e]); b[e] = -__expf(alog[4 + e]) * softplusf_(v1[e] + dtb[4 + e]); }
                float* fo = (float*)(ws + WS_GB) + (size_t)row * 16; *(f32x4*)fo = a; *(f32x4*)(fo + 4) = b;
            } else if (cc == 16) { f32x4 a, b;
#pragma unroll
                for (int e = 0; e < 4; ++e) { a[e] = sigmoidf_(v0[e]); b[e] = sigmoidf_(v1[e]); }
                float* fo = (float*)(ws + WS_GB) + (size_t)row * 16 + 8; *(f32x4*)fo = a; *(f32x4*)(fo + 4) = b;
            }
        }
    }
#define EPI_ROWS(PNEXPR) do { _Pragma("unroll") for (int ai = 0; ai < 2; ++ai) _Pragma("unroll") for (int m = 0; m < 4; ++m) { const int row = u.pm * 256 + ai * 128 + wr * 64 + m * 16 + fr; \
            _Pragma("unroll") for (int bj = 0; bj < 2; ++bj) emit((PNEXPR), row, bj * 128 + wc * 32 + 8 * fq, acc[ai][bj][m][0], acc[ai][bj][m][1]); } } while (0)
    __device__ __forceinline__ void operator()(const f32x4 (&acc)[2][2][4][2], const Unit& u, int wr, int wc, int fr, int fq) const {
        const int pn = u.pn;
        if (pn < 2) EPI_ROWS(pn & 1);
        else if (pn < 4) EPI_ROWS(2 + (pn & 1));
        else if (pn < 6) EPI_ROWS(4 + (pn & 1));
        else if (pn < 12) EPI_ROWS(pn < 9 ? (pn < 7 ? 6 : (pn < 8 ? 7 : 8)) : (pn < 10 ? 9 : (pn < 11 ? 10 : 11)));
        else if (pn < 14) EPI_ROWS(12 + (pn & 1));
        else if (pn < 22) EPI_ROWS(pn < 18 ? (pn < 16 ? (pn < 15 ? 14 : 15) : (pn < 17 ? 16 : 17)) : (pn < 20 ? (pn < 19 ? 18 : 19) : (pn < 21 ? 20 : 21)));
        else { if (wc == 0 && fq < 3) {
#pragma unroll
            for (int ai = 0; ai < 2; ++ai)
#pragma unroll
                for (int m = 0; m < 4; ++m) { const int row = u.pm * 256 + ai * 128 + wr * 64 + m * 16 + fr; emit(22, row, 8 * fq, acc[ai][0][m][0], acc[ai][0][m][1]); } } }
    }
#undef EPI_ROWS
};
template <int MODE> struct EpiBf {
    static constexpr bool PERM = true, AFTER_DRAIN = false;
    float* out; unsigned char* ws;
    __device__ __forceinline__ void operator()(const f32x4 (&acc)[2][2][4][2], const Unit& u, int wr, int wc, int fr, int fq) const {
#pragma unroll
        for (int ai = 0; ai < 2; ++ai)
#pragma unroll
            for (int m = 0; m < 4; ++m) { const int row = u.pm * 256 + ai * 128 + wr * 64 + m * 16 + fr;
#pragma unroll
                for (int bj = 0; bj < 2; ++bj) { const int c = u.pn * 256 + bj * 128 + wc * 32 + 8 * fq; f32x4 v0 = acc[ai][bj][m][0], v1 = acc[ai][bj][m][1];
                    if (MODE == 2) {
#pragma unroll
                        for (int e = 0; e < 4; ++e) { const float a = fmaxf(v0[e], 0.f), b = fmaxf(v1[e], 0.f); v0[e] = a * a; v1[e] = b * b; }
                        __builtin_nontemporal_store(pack8(v0, v1), (u32x4*)((bf16_t*)(ws + WS_H) + ((size_t)row * DFF + c)));
                    } else {
                        const u32x4 gt = *(const u32x4*)((const bf16_t*)out + ((size_t)row * 2048 + (MODE == 1 ? 1024 : 0) + c));
                        const f32x4 g0 = {bflo(gt.x), bfhi(gt.x), bflo(gt.y), bfhi(gt.y)}, g1 = {bflo(gt.z), bfhi(gt.z), bflo(gt.w), bfhi(gt.w)};
                        v0 = v0 * g0; v1 = v1 * g1;
                        bf16_t* tp = (bf16_t*)(ws + WS_TMP) + ((size_t)row * 1024 + c);
                        if (MODE == 0) *(u32x4*)tp = pack8(v0, v1);
                        else { const u32x4 t = *(const u32x4*)tp; const f32x4 t0 = {bflo(t.x), bfhi(t.x), bflo(t.y), bfhi(t.y)}, t1 = {bflo(t.z), bfhi(t.z), bflo(t.w), bfhi(t.w)};
                            *(u32x4*)((bf16_t*)(ws + WS_MB) + ((size_t)row * 1024 + c)) = pack8(v0 + t0, v1 + t1); }
                    } } }
    }
};
struct EpiF32SS {
    static constexpr bool PERM = true, AFTER_DRAIN = false;
    float* dst; float* rowss;
    __device__ __forceinline__ void operator()(const f32x4 (&acc)[2][2][4][2], const Unit& u, int wr, int wc, int fr, int fq) const {
#pragma unroll
        for (int ai = 0; ai < 2; ++ai)
#pragma unroll
            for (int m = 0; m < 4; ++m) { const int row = u.pm * 256 + ai * 128 + wr * 64 + m * 16 + fr; float s = 0.f;
#pragma unroll
                for (int bj = 0; bj < 2; ++bj) { const int c = u.pn * 256 + bj * 128 + wc * 32 + 8 * fq; const f32x4 v0 = acc[ai][bj][m][0], v1 = acc[ai][bj][m][1];
                    *(u32x4*)((bf16_t*)dst + (size_t)row * 1024 + c) = pack8(v0, v1);
#pragma unroll
                    for (int e = 0; e < 4; ++e) s += v0[e] * v0[e] + v1[e] * v1[e]; }
                s += __shfl_xor(s, 16); s += __shfl_xor(s, 32);
                if (fq == 0) rowss[(size_t)row * 16 + u.pn * 4 + wc] = s; }
    }
};

struct SplitOrder {
    int bid;
    __device__ __forceinline__ bool next(int i, Unit& u) const { if (i > 0 || bid >= 16) return false; u.pm = 128; u.pn = bid & 3; return true; }
    __device__ __forceinline__ void a_ready(const Unit&) const {}
    __device__ __forceinline__ void done(const Unit&) const {}
};
struct EpiPart {
    static constexpr bool PERM = true, AFTER_DRAIN = false;
    float* dst;
    __device__ __forceinline__ void operator()(const f32x4 (&acc)[2][2][4][2], const Unit& u, int wr, int wc, int fr, int fq) const {
#pragma unroll
        for (int ai = 0; ai < 2; ++ai)
#pragma unroll
            for (int m = 0; m < 4; ++m) { const int row = ai * 128 + wr * 64 + m * 16 + fr;
#pragma unroll
                for (int bj = 0; bj < 2; ++bj) { const int c = u.pn * 256 + bj * 128 + wc * 32 + 8 * fq; float* fo = dst + (size_t)row * 1024 + c; *(f32x4*)fo = acc[ai][bj][m][0]; *(f32x4*)(fo + 4) = acc[ai][bj][m][1]; } }
    }
};

__device__ __forceinline__ int srccol(int n) {
    if (n < 1536) return n;
    if (n < 3072) return n + 8;
    if (n < 5632) return n + 24;
    if (n < 5640) return 1536 + (n - 5632);
    if (n < 5648) return 3080 + (n - 5640);
    if (n < 5656) return 3088 + (n - 5648);
    return -1;
}
__device__ __forceinline__ void phase0(KP p, unsigned char* lds, const int mk_wid) {
    const int wid = mk_wid, tid = mk_tid(mk_wid), lane = tid & 63, nbt = gridDim.x, bidt = blockIdx.x;
    const int nbw = (nbt * 3) / 8;
    const int nb = bidt < nbw ? nbw : nbt - nbw, bid = bidt < nbw ? bidt : bidt - nbw; const bool do_w = bidt < nbw, do_x = bidt >= nbw;
    unsigned* ctl = (unsigned*)(p->ws + WS_CTL);
    for (int i = bidt * 512 + tid; i < (int)(CTL_BYTES / 4); i += nbt * 512) ctl[i] = 0u;
    float* tile = (float*)lds;
    if (do_w) {
#define TDECODE(t) do { remap = false; \
        if ((t) < 1472) { src = p->in[7]; ldsrc = 5656; K = 1024; dst = (bf16_t*)(p->ws + WS_WIN); n0 = ((t) >> 4) * 64; k0 = ((t) & 15) * 64; remap = true; } \
        else if ((t) < 1600) { const int q = (t) - 1472; src = p->in[13]; ldsrc = 1024; K = 512; dst = (bf16_t*)(p->ws + WS_WPA); n0 = (q >> 3) * 64; k0 = (q & 7) * 64; } \
        else if ((t) < 1728) { const int q = (t) - 1600; src = p->in[14]; ldsrc = 1024; K = 512; dst = (bf16_t*)(p->ws + WS_WPB); n0 = (q >> 3) * 64; k0 = (q & 7) * 64; } \
        else if ((t) < 1984) { const int q = (t) - 1728; src = p->in[15]; ldsrc = 1024; K = 1024; dst = (bf16_t*)(p->ws + WS_WOUT); n0 = (q >> 4) * 64; k0 = (q & 15) * 64; } \
        else if ((t) < 3008) { const int q = (t) - 1984; src = p->in[20]; ldsrc = 4096; K = 1024; dst = (bf16_t*)(p->ws + WS_WUP); n0 = (q >> 4) * 64; k0 = (q & 15) * 64; } \
        else { const int q = (t) - 3008; src = p->in[21]; ldsrc = 1024; K = 4096; dst = (bf16_t*)(p->ws + WS_WDN); n0 = (q >> 6) * 64; k0 = (q & 63) * 64; } } while (0)
#define TLOAD(tv) do { const int nn = tid & 63; int col = n0 + nn; if (remap) col = srccol(col); \
        _Pragma("unroll") for (int i = 0; i < 8; ++i) { const int kk = (tid >> 6) + 8 * i; tv[i] = col >= 0 ? __builtin_nontemporal_load(src + (size_t)(k0 + kk) * ldsrc + col) : 0.f; } } while (0)
        const float* src; bf16_t* dst; int ldsrc, K, n0, k0; bool remap; float tv[8];
        int t = bid;
        if (t < 4032) { TDECODE(t); TLOAD(tv); }
        for (; t < 4032; t += nb) {
            bf16_t* dcur = dst; const int Kc = K, n0c = n0, k0c = k0;
            { const int nn = tid & 63;
#pragma unroll
              for (int i = 0; i < 8; ++i) { const int kk = (tid >> 6) + 8 * i; tile[kk * 65 + nn] = tv[i]; } }
            __syncthreads();
            if (t + nb < 4032) { TDECODE(t + nb); TLOAD(tv); }
            __builtin_amdgcn_sched_barrier(0);
            { const int nn = tid >> 3, kq = tid & 7; float v[8];
#pragma unroll
              for (int jx = 0; jx < 8; ++jx) v[jx] = tile[(kq * 8 + jx) * 65 + nn];
              u32x4 w; w.x = cvtpk(v[0], v[1]); w.y = cvtpk(v[2], v[3]); w.z = cvtpk(v[4], v[5]); w.w = cvtpk(v[6], v[7]);
              *(u32x4*)(dcur + (size_t)(n0c + nn) * Kc + k0c + kq * 8) = w; }
            __syncthreads();
        }
#undef TDECODE
#undef TLOAD
    }
    if (do_x) { const float* gain = p->in[16]; bf16_t* XN = (bf16_t*)(p->ws + WS_XN);
      for (int rowa = bid * 8 + wid; rowa < MROWS; rowa += 2 * nb * 8) {
          int rows[2]; rows[0] = rowa; rows[1] = rowa + nb * 8 < MROWS ? rowa + nb * 8 : rowa;
          f32x4 v[2][4];
#pragma unroll
          for (int q = 0; q < 2; ++q) { const int row = rows[q]; const float* xr = row < NPROMPT ? p->in[0] + (size_t)row * 1024 : p->in[1] + (size_t)(row - NPROMPT) * 1024;
#pragma unroll
              for (int i = 0; i < 4; ++i) v[q][i] = __builtin_nontemporal_load((const f32x4*)(xr + lane * 4 + 256 * i)); }
          __builtin_amdgcn_sched_barrier(0);
#pragma unroll
          for (int q = 0; q < 2; ++q) { const int row = rows[q]; float ss = 0.f;
#pragma unroll
              for (int i = 0; i < 4; ++i) ss += v[q][i][0] * v[q][i][0] + v[q][i][1] * v[q][i][1] + v[q][i][2] * v[q][i][2] + v[q][i][3] * v[q][i][3];
              ss = wave_sum(ss); const float rs = rsqrtf(ss * (1.0f / 1024.0f) + EPS);
#pragma unroll
              for (int i = 0; i < 4; ++i) { const f32x4 g = *(const f32x4*)(gain + lane * 4 + 256 * i); const f32x4 y = v[q][i] * rs * g;
                  u32x2 w; w.x = cvtpk(y[0], y[1]); w.y = cvtpk(y[2], y[3]); *(u32x2*)(XN + (size_t)row * 1024 + lane * 4 + 256 * i) = w; } } } }
    if (do_x) { bf16_t* KS = (bf16_t*)(p->ws + WS_KS); bf16_t* VS = (bf16_t*)(p->ws + WS_VS);
      for (int e0 = bid * 512 + tid; e0 < 4194304; e0 += 4 * nb * 512) { f32x4 kv[4], vv[4];
#pragma unroll
          for (int q = 0; q < 4; ++q) { const int e = e0 + q * nb * 512; if (e < 4194304) { kv[q] = __builtin_nontemporal_load((const f32x4*)p->in[2] + e); vv[q] = __builtin_nontemporal_load((const f32x4*)p->in[3] + e); } }
          __builtin_amdgcn_sched_barrier(0);
#pragma unroll
          for (int q = 0; q < 4; ++q) { const int e = e0 + q * nb * 512; if (e < 4194304) { const int b = e >> 18, rem = e & 262143, r = rem >> 7, c4 = rem & 127; const size_t o = ((size_t)(b * SKV + r) * 512 + c4 * 4);
              u32x2 w; w.x = cvtpk(kv[q][0], kv[q][1]); w.y = cvtpk(kv[q][2], kv[q][3]); *(u32x2*)(KS + o) = w; w.x = cvtpk(vv[q][0], vv[q][1]); w.y = cvtpk(vv[q][2], vv[q][3]); *(u32x2*)(VS + o) = w; } } }
      const u32x4 z4 = {0u, 0u, 0u, 0u};
      for (int e = bid * 512 + tid; e < 245760; e += nb * 512) { const int b = e / 15360, rem = e % 15360, r = 2064 + (rem >> 6), c = (rem & 63) * 8; const size_t o = ((size_t)(b * SKV + r) * 512 + c);
          *(u32x4*)(KS + o) = z4; *(u32x4*)(VS + o) = z4; }
      u32x4* QS = (u32x4*)(p->ws + WS_QS);
      for (int e = bid * 512 + tid; e < 262144; e += nb * 512) QS[e] = z4; }
}

__device__ __forceinline__ void cumsum_unit(KP p, int cu, unsigned char* lds, const int mk_wid) {
    const int wid = mk_wid, tid = mk_tid(mk_wid), lane = tid & 63;
    float* wt = (float*)lds;
    const bool samp = cu >= 4; const int b = samp ? cu - 4 : cu; const int L = samp ? SKV : SEQ; const int nthr = L / 16;
    const float* src = nullptr;
    if (tid < nthr) { const int t0 = tid * 16;
        if (!samp) src = p->out + O_LFP + (size_t)(b * SEQ + t0) * 8;
        else if (t0 < PAST) src = p->in[4] + (size_t)(b * PAST + t0) * 8;
        else if (t0 < PAST + 16) src = p->out + O_LFS + (size_t)(b * 16) * 8; }
    float tot[8];
#pragma unroll
    for (int h = 0; h < 8; ++h) tot[h] = 0.f;
    if (src) {
#pragma unroll 4
        for (int r = 0; r < 16; ++r) { const f32x4 a = *(const f32x4*)(src + r * 8), c = *(const f32x4*)(src + r * 8 + 4);
            tot[0] += a[0]; tot[1] += a[1]; tot[2] += a[2]; tot[3] += a[3]; tot[4] += c[0]; tot[5] += c[1]; tot[6] += c[2]; tot[7] += c[3]; } }
    float pre[8];
#pragma unroll
    for (int h = 0; h < 8; ++h) { float v = tot[h];
#pragma unroll
        for (int o = 1; o < 64; o <<= 1) { const float t = __shfl_up(v, o); if (lane >= o) v += t; }
        pre[h] = v - tot[h];
        if (lane == 63) wt[wid * 8 + h] = v; }
    __syncthreads();
#pragma unroll
    for (int h = 0; h < 8; ++h) { float s = 0.f; for (int w = 0; w < wid; ++w) s += wt[w * 8 + h]; pre[h] += s; }
    if (tid < nthr) { float* G = (float*)(p->ws + (samp ? WS_GCS : WS_GCP)) + (size_t)(b * 8) * L + tid * 16;
#pragma unroll
        for (int q = 0; q < 4; ++q) { f32x4 o[8];
#pragma unroll
            for (int r = 0; r < 4; ++r) { f32x4 a = {0.f, 0.f, 0.f, 0.f}, c = a; if (src) { a = *(const f32x4*)(src + (q * 4 + r) * 8); c = *(const f32x4*)(src + (q * 4 + r) * 8 + 4); }
                pre[0] += a[0]; pre[1] += a[1]; pre[2] += a[2]; pre[3] += a[3]; pre[4] += c[0]; pre[5] += c[1]; pre[6] += c[2]; pre[7] += c[3];
#pragma unroll
                for (int h = 0; h < 8; ++h) o[h][r] = pre[h]; }
#pragma unroll
            for (int h = 0; h < 8; ++h) *(f32x4*)(G + (size_t)h * L + q * 4) = o[h]; } }
    __syncthreads();
}

__device__ __forceinline__ void norm_unit(KP p, int nu, const int mk_wid) {
    const int wid = mk_wid, tid = mk_tid(mk_wid), lane = tid & 63;
    const bool samp = nu >= 128; const int b = samp ? (nu - 128) / 9 : nu >> 5, rb = samp ? (nu - 128) % 9 : nu & 31;
    const bf16_t* Kp = samp ? (const bf16_t*)(p->ws + WS_KS) + (size_t)(b * SKV + 256 * rb + 32 * wid) * 512 : (const bf16_t*)(p->ws + WS_KP) + (size_t)(b * SEQ + 256 * rb + 32 * wid) * 512;
    const bf16_t* Qp = samp ? (const bf16_t*)(p->ws + WS_QS) + (size_t)(b * 256 + 32 * wid) * 512 : (const bf16_t*)(p->ws + WS_QP) + (size_t)(b * SEQ + 256 * rb + 32 * wid) * 512;
    const bool hasq = !samp || rb == 0;
    unsigned* NRM = (unsigned*)(p->ws + WS_CTL) + 512 + ((samp ? 32 : 0) + b * 8) * 2;
    float kmax = 0.f, qmax = 0.f;
#pragma unroll 8
    for (int r = 0; r < 32; ++r) { const u32x4 kw = *(const u32x4*)(Kp + (size_t)r * 512 + lane * 8); u32x4 qw = {0u, 0u, 0u, 0u}; if (hasq) qw = *(const u32x4*)(Qp + (size_t)r * 512 + lane * 8);
        float k2 = bflo(kw.x) * bflo(kw.x) + bfhi(kw.x) * bfhi(kw.x) + bflo(kw.y) * bflo(kw.y) + bfhi(kw.y) * bfhi(kw.y) + bflo(kw.z) * bflo(kw.z) + bfhi(kw.z) * bfhi(kw.z) + bflo(kw.w) * bflo(kw.w) + bfhi(kw.w) * bfhi(kw.w);
        float q2 = bflo(qw.x) * bflo(qw.x) + bfhi(qw.x) * bfhi(qw.x) + bflo(qw.y) * bflo(qw.y) + bfhi(qw.y) * bfhi(qw.y) + bflo(qw.z) * bflo(qw.z) + bfhi(qw.z) * bfhi(qw.z) + bflo(qw.w) * bflo(qw.w) + bfhi(qw.w) * bfhi(qw.w);
        k2 += __shfl_xor(k2, 1); k2 += __shfl_xor(k2, 2); k2 += __shfl_xor(k2, 4); q2 += __shfl_xor(q2, 1); q2 += __shfl_xor(q2, 2); q2 += __shfl_xor(q2, 4);
        kmax = fmaxf(kmax, k2); qmax = fmaxf(qmax, q2); }
    if ((lane & 7) == 0) { const int h = lane >> 3; atomicMax(NRM + h * 2 + 1, __float_as_uint(kmax)); if (hasq) atomicMax(NRM + h * 2, __float_as_uint(qmax)); }
}

__device__ __forceinline__ void sdesc(int u, int k, int& b, int& h, int& zrow0, int& tt0, int& nvalid, int& cid, bool& samp) {
    if (u < 1024) { const int bh = u >> 5, chunk = 4 * (u & 31) + k; b = bh >> 3; h = bh & 7; zrow0 = b * SEQ + 64 * chunk; tt0 = 64 * chunk; nvalid = 64; cid = bh * 128 + chunk; samp = false; }
    else { const int bh = 4 * (u - 1024) + k; b = bh >> 3; h = bh & 7; zrow0 = NPROMPT + b * 16; tt0 = 0; nvalid = 16; cid = 4096 + bh; samp = true; }
}
__device__ __forceinline__ void g1_unit(KP p, int u, unsigned char* lds, const int mk_wid) {
    const int wid = mk_wid, tid = mk_tid(mk_wid), lane = tid & 63;
    bf16_t* KB = (bf16_t*)lds;
    bf16_t* VB = (bf16_t*)(lds + 36864);
    float* LM = (float*)(lds + 73728);
    float* GC = (float*)(lds + 139264);
    float* BT = GC + 256; float* EG = BT + 256;
    const bf16_t* ZC = (const bf16_t*)(p->ws + WS_ZC);
    bf16_t* qG = (bf16_t*)(p->ws + WS_QG); bf16_t* kG = (bf16_t*)(p->ws + WS_KG); bf16_t* kTG = (bf16_t*)(p->ws + WS_KTG); bf16_t* wG = (bf16_t*)(p->ws + WS_WG); bf16_t* uTG = (bf16_t*)(p->ws + WS_UTG);
    float* gcG = (float*)(p->ws + WS_GCG); const float* GB = (const float*)(p->ws + WS_GB);
    { const int cg8 = tid & 7, tg = tid >> 3, slot = tg >> 4, c0 = 4 * (tg & 15);
      int b, h, zrow0, tt0, nvalid, cid; bool samp; sdesc(u, slot, b, h, zrow0, tt0, nvalid, cid, samp);
      u32x4 zr[3][7];
#pragma unroll
      for (int sec = 0; sec < 3; ++sec)
#pragma unroll
          for (int d = 0; d < 7; ++d) { const int cc = c0 - 3 + d; zr[sec][d] = (u32x4){0u, 0u, 0u, 0u};
              if (c0 < nvalid && tt0 + cc >= 0) zr[sec][d] = *(const u32x4*)(ZC + (size_t)(zrow0 + cc) * 1536 + sec * 512 + h * 64 + cg8 * 8); }
      __builtin_amdgcn_sched_barrier(0);
#pragma unroll
      for (int sec = 0; sec < 3; ++sec) {
          const int ch = sec * 512 + h * 64 + cg8 * 8; float o[4][8];
          if (c0 < nvalid) {
              float w[4][8], r[7][8];
#pragma unroll
              for (int i = 0; i < 4; ++i) { const f32x4 a = *(const f32x4*)(p->in[9] + i * 1536 + ch), c = *(const f32x4*)(p->in[9] + i * 1536 + ch + 4);
                  w[i][0] = a[0]; w[i][1] = a[1]; w[i][2] = a[2]; w[i][3] = a[3]; w[i][4] = c[0]; w[i][5] = c[1]; w[i][6] = c[2]; w[i][7] = c[3]; }
#pragma unroll
              for (int d = 0; d < 7; ++d) { const int cc = c0 - 3 + d, s = tt0 + cc;
                  if (s < 0) {
                      if (samp) { const float* cp = p->in[6] + (size_t)(b * 3 + 3 + s) * 1536 + ch; const f32x4 a = *(const f32x4*)cp, c = *(const f32x4*)(cp + 4);
                          r[d][0] = a[0]; r[d][1] = a[1]; r[d][2] = a[2]; r[d][3] = a[3]; r[d][4] = c[0]; r[d][5] = c[1]; r[d][6] = c[2]; r[d][7] = c[3]; }
                      else {
#pragma unroll
                          for (int e = 0; e < 8; ++e) r[d][e] = 0.f; }
                  } else { const u32x4 z = zr[sec][d];
                      r[d][0] = bflo(z.x); r[d][1] = bfhi(z.x); r[d][2] = bflo(z.y); r[d][3] = bfhi(z.y); r[d][4] = bflo(z.z); r[d][5] = bfhi(z.z); r[d][6] = bflo(z.w); r[d][7] = bfhi(z.w); } }
#pragma unroll
              for (int t = 0; t < 4; ++t)
#pragma unroll
                  for (int e = 0; e < 8; ++e) { const float y = w[0][e] * r[t][e] + w[1][e] * r[t + 1][e] + w[2][e] * r[t + 2][e] + w[3][e] * r[t + 3][e]; o[t][e] = y * sigmoidf_(y); }
          } else {
#pragma unroll
              for (int t = 0; t < 4; ++t)
#pragma unroll
                  for (int e = 0; e < 8; ++e) o[t][e] = 0.f; }
#pragma unroll
          for (int t = 0; t < 4; ++t) {
              float sc = 1.f;
              if (sec < 2) { float ss = 0.f;
#pragma unroll
                  for (int e = 0; e < 8; ++e) ss += o[t][e] * o[t][e];
                  ss += __shfl_xor(ss, 1); ss += __shfl_xor(ss, 2); ss += __shfl_xor(ss, 4);
                  sc = rsqrtf(ss + EPS) * (sec == 0 ? 0.125f : 1.0f); }
              u32x4 wv; wv.x = cvtpk(o[t][0] * sc, o[t][1] * sc); wv.y = cvtpk(o[t][2] * sc, o[t][3] * sc); wv.z = cvtpk(o[t][4] * sc, o[t][5] * sc); wv.w = cvtpk(o[t][6] * sc, o[t][7] * sc);
              const int c = c0 + t;
              if (sec == 0) *(u32x4*)(qG + (size_t)cid * 4096 + c * 64 + cg8 * 8) = wv;
              else if (sec == 1) { *(u32x4*)(KB + (slot * 64 + c) * 72 + cg8 * 8) = wv; *(u32x4*)(kG + (size_t)cid * 4096 + c * 64 + cg8 * 8) = wv; }
              else *(u32x4*)(VB + (slot * 64 + c) * 72 + cg8 * 8) = wv; } } }
    if (tid < 256) { int b, h, zrow0, tt0, nvalid, cid; bool samp; sdesc(u, wid, b, h, zrow0, tt0, nvalid, cid, samp);
        float g = 0.f, bt = 0.f; if (lane < nvalid) { g = GB[(size_t)(zrow0 + lane) * 16 + h]; bt = GB[(size_t)(zrow0 + lane) * 16 + 8 + h]; }
#pragma unroll
        for (int o = 1; o < 64; o <<= 1) { const float t = __shfl_up(g, o); if (lane >= o) g += t; }
        GC[wid * 64 + lane] = g; BT[wid * 64 + lane] = bt; EG[wid * 64 + lane] = __expf(g); gcG[(size_t)cid * 64 + lane] = g; }
    __syncthreads();
    const int slot3 = tid >> 7, col = tid & 127;
    int b3, h3, zrow3, tt3, nv3, cid3; bool samp3; sdesc(u, slot3, b3, h3, zrow3, tt3, nv3, cid3, samp3);
    float x[64];
    if (col < 64) {
#pragma unroll
        for (int i = 0; i < 64; ++i) x[i] = (i < nv3) ? bf2f(VB[(slot3 * 64 + i) * 72 + col]) * BT[slot3 * 64 + i] : 0.f;
    } else { const int dk = col - 64; const float glast = GC[slot3 * 64 + 63];
#pragma unroll
        for (int i8 = 0; i8 < 8; ++i8) { float kt[8];
#pragma unroll
            for (int e = 0; e < 8; ++e) { const int i = i8 * 8 + e; const float kv = bf2f(KB[(slot3 * 64 + i) * 72 + dk]); x[i] = kv * BT[slot3 * 64 + i] * EG[slot3 * 64 + i]; kt[e] = kv * __expf(glast - GC[slot3 * 64 + i]); }
            u32x4 wv; wv.x = cvtpk(kt[0], kt[1]); wv.y = cvtpk(kt[2], kt[3]); wv.z = cvtpk(kt[4], kt[5]); wv.w = cvtpk(kt[6], kt[7]);
            *(u32x4*)(kTG + (size_t)cid3 * 4096 + dk * 64 + i8 * 8) = wv; } }
    { const int slotw = wid >> 1, half = wid & 1, g = lane >> 4, r16 = lane & 15;
      int nvw, d0_, d1_, d2_, d3_, d4_; bool d5_; sdesc(u, slotw, d0_, d1_, d2_, d3_, nvw, d4_, d5_);
      for (int it = 2 * half; it < 2 * half + 2; ++it)
          for (int jt = 0; jt <= it && 16 * it < nvw; ++jt) { f32x4 acc = {0.f, 0.f, 0.f, 0.f};
#pragma unroll
              for (int ks = 0; ks < 2; ++ks) { const bf16x8 a = *(const bf16x8*)(KB + (slotw * 64 + 16 * it + r16) * 72 + 32 * ks + 8 * g), bb = *(const bf16x8*)(KB + (slotw * 64 + 16 * jt + r16) * 72 + 32 * ks + 8 * g);
                  acc = MFMA16(a, bb, acc); }
              const int j = 16 * jt + r16; const float gcj = GC[slotw * 64 + j];
#pragma unroll
              for (int r = 0; r < 4; ++r) { const int i = 16 * it + 4 * g + r; LM[(slotw * 64 + i) * 64 + j] = (i > j) ? acc[r] * BT[slotw * 64 + i] * __expf(GC[slotw * 64 + i] - gcj) : 0.f; } } }
    __syncthreads();
    { const float* Lr = LM + slot3 * 4096;
#pragma unroll
      for (int i = 1; i < 64; ++i) if (i < nv3) { float a = x[i];
#pragma unroll
          for (int j4 = 0; j4 < (i + 3) / 4; ++j4) { const f32x4 lv = *(const f32x4*)(Lr + i * 64 + 4 * j4);
#pragma unroll
              for (int e = 0; e < 4; ++e) if (4 * j4 + e < i) a -= lv[e] * x[4 * j4 + e]; }
          x[i] = a; } }
    if (col < 64) {
#pragma unroll
        for (int i8 = 0; i8 < 8; ++i8) { u32x4 wv; wv.x = cvtpk(x[i8 * 8], x[i8 * 8 + 1]); wv.y = cvtpk(x[i8 * 8 + 2], x[i8 * 8 + 3]); wv.z = cvtpk(x[i8 * 8 + 4], x[i8 * 8 + 5]); wv.w = cvtpk(x[i8 * 8 + 6], x[i8 * 8 + 7]);
            *(u32x4*)(uTG + (size_t)cid3 * 4096 + col * 64 + i8 * 8) = wv; }
    } else { const int dk = col - 64;
#pragma unroll
        for (int i = 0; i < 64; i += 2) { const unsigned w2 = cvtpk(x[i], x[i + 1]); VB[(slot3 * 64 + i) * 72 + dk] = (bf16_t)(w2 & 0xffffu); VB[(slot3 * 64 + i + 1) * 72 + dk] = (bf16_t)(w2 >> 16); } }
    __syncthreads();
#pragma unroll
    for (int q = 0; q < 4; ++q) { const int piece = tid + 512 * q, slotc = piece >> 9, rem = piece & 511, c = rem >> 3, pc = rem & 7;
        int b, h, zrow0, tt0, nvalid, cid; bool samp; sdesc(u, slotc, b, h, zrow0, tt0, nvalid, cid, samp);
        *(u32x4*)(wG + (size_t)cid * 4096 + c * 64 + pc * 8) = *(const u32x4*)(VB + (slotc * 64 + c) * 72 + pc * 8); }
    __syncthreads();
}

__device__ __forceinline__ void g2_task(KP p, int cid0, int nchunks, int dv0, const float* s_init, float* s_out, int lane) {
    const int g = lane >> 4, r16 = lane & 15;
    const bf16_t* wG = (const bf16_t*)(p->ws + WS_WG); const bf16_t* kTG = (const bf16_t*)(p->ws + WS_KTG); const bf16_t* uTG = (const bf16_t*)(p->ws + WS_UTG); const float* gcG = (const float*)(p->ws + WS_GCG);
    bf16_t* vnT = (bf16_t*)(p->ws + WS_VNT); bf16_t* ST = (bf16_t*)(p->ws + WS_ST);
    f32x4 S[4];
#pragma unroll
    for (int mt = 0; mt < 4; ++mt)
#pragma unroll
        for (int r = 0; r < 4; ++r) S[mt][r] = s_init ? s_init[(16 * mt + 4 * g + r) * 64 + dv0 + r16] : 0.f;
#define G2_LOAD(UU, AW, AK, GL, n_) do { const size_t cb_ = (size_t)(cid0 + (n_)) * 4096; const bf16_t* wp = wG + cb_; const bf16_t* kp = kTG + cb_; const bf16_t* up = uTG + cb_ + (dv0 + r16) * 64; \
        _Pragma("unroll") for (int mt = 0; mt < 4; ++mt) { UU[mt] = *(const u32x2*)(up + 16 * mt + 4 * g); \
            _Pragma("unroll") for (int ks = 0; ks < 2; ++ks) { AW[mt][ks] = ld2x8(wp + (16 * mt + r16) * 64 + 32 * ks + 4 * g, wp + (16 * mt + r16) * 64 + 32 * ks + 16 + 4 * g); \
                AK[mt][ks] = ld2x8(kp + (16 * mt + r16) * 64 + 32 * ks + 4 * g, kp + (16 * mt + r16) * 64 + 32 * ks + 16 + 4 * g); } } \
        GL = gcG[(size_t)(cid0 + (n_)) * 64 + 63]; } while (0)
#define G2_STEP(UU, AW, AK, GL, n_) do { const size_t cb = (size_t)(cid0 + (n_)) * 4096; f32x4 acc[4]; \
        _Pragma("unroll") for (int mt = 0; mt < 4; ++mt) acc[mt] = (f32x4){bflo(UU[mt].x), bfhi(UU[mt].x), bflo(UU[mt].y), bfhi(UU[mt].y)}; \
        const float eg = __expf(GL); \
        _Pragma("unroll") for (int mt = 0; mt < 4; ++mt) { u32x2 w; w.x = cvtpk(S[mt][0], S[mt][1]); w.y = cvtpk(S[mt][2], S[mt][3]); *(u32x2*)(ST + cb + (dv0 + r16) * 64 + 16 * mt + 4 * g) = w; } \
        bf16x8 Bs[2]; \
        _Pragma("unroll") for (int ks = 0; ks < 2; ++ks) Bs[ks] = __builtin_bit_cast(bf16x8, pack8(-S[2 * ks], -S[2 * ks + 1])); \
        _Pragma("unroll") for (int mt = 0; mt < 4; ++mt) _Pragma("unroll") for (int ks = 0; ks < 2; ++ks) acc[mt] = MFMA16(AW[mt][ks], Bs[ks], acc[mt]); \
        _Pragma("unroll") for (int mt = 0; mt < 4; ++mt) { u32x2 w; w.x = cvtpk(acc[mt][0], acc[mt][1]); w.y = cvtpk(acc[mt][2], acc[mt][3]); *(u32x2*)(vnT + cb + (dv0 + r16) * 64 + 16 * mt + 4 * g) = w; } \
        bf16x8 Bv[2]; \
        _Pragma("unroll") for (int ks = 0; ks < 2; ++ks) Bv[ks] = __builtin_bit_cast(bf16x8, pack8(acc[2 * ks], acc[2 * ks + 1])); \
        _Pragma("unroll") for (int mt = 0; mt < 4; ++mt) { S[mt] = S[mt] * eg; \
            _Pragma("unroll") for (int ks = 0; ks < 2; ++ks) S[mt] = MFMA16(AK[mt][ks], Bv[ks], S[mt]); } } while (0)
    u32x2 uA[4], uB[4]; bf16x8 wA[4][2], kA[4][2], wB[4][2], kB[4][2]; float gA, gB;
    G2_LOAD(uA, wA, kA, gA, 0);
    __builtin_amdgcn_sched_barrier(0);
    for (int n = 0; n < nchunks; n += 2) {
        { const int n1 = (n + 1 < nchunks) ? n + 1 : nchunks - 1; G2_LOAD(uB, wB, kB, gB, n1); }
        __builtin_amdgcn_sched_barrier(0);
        G2_STEP(uA, wA, kA, gA, n);
        __builtin_amdgcn_sched_barrier(0);
        { const int n2 = (n + 2 < nchunks) ? n + 2 : nchunks - 1; G2_LOAD(uA, wA, kA, gA, n2); }
        __builtin_amdgcn_sched_barrier(0);
        if (n + 1 < nchunks) G2_STEP(uB, wB, kB, gB, n + 1);
        __builtin_amdgcn_sched_barrier(0);
    }
#undef G2_LOAD
#undef G2_STEP
#pragma unroll
    for (int mt = 0; mt < 4; ++mt)
#pragma unroll
        for (int r = 0; r < 4; ++r) s_out[(16 * mt + 4 * g + r) * 64 + dv0 + r16] = S[mt][r];
}

__device__ __forceinline__ void g2_scan_lds(KP p, int s, int dv0, float* s_out, int lane, unsigned char* lds) {
    const int g = lane >> 4, r16 = lane & 15;
    const bf16_t* wG = (const bf16_t*)(p->ws + WS_WG); const bf16_t* kTG = (const bf16_t*)(p->ws + WS_KTG); const bf16_t* uTG = (const bf16_t*)(p->ws + WS_UTG); const float* gcG = (const float*)(p->ws + WS_GCG);
    bf16_t* vnT = (bf16_t*)(p->ws + WS_VNT); bf16_t* ST = (bf16_t*)(p->ws + WS_ST);
    bf16_t* Lw = (bf16_t*)lds; bf16_t* Lk = Lw + 64 * 72; bf16_t* Lu = Lk + 64 * 72;
    f32x4 S[4];
#pragma unroll
    for (int mt = 0; mt < 4; ++mt) S[mt] = (f32x4){0.f, 0.f, 0.f, 0.f};
    u32x4 rw[8], rk[8], ru[2]; float gl;
#define G2L_LOAD(n_) do { const size_t cb_ = (size_t)(s * 128 + (n_)) * 4096; \
        _Pragma("unroll") for (int q = 0; q < 8; ++q) { rw[q] = *(const u32x4*)(wG + cb_ + (size_t)(lane + 64 * q) * 8); rk[q] = *(const u32x4*)(kTG + cb_ + (size_t)(lane + 64 * q) * 8); } \
        _Pragma("unroll") for (int q = 0; q < 2; ++q) ru[q] = *(const u32x4*)(uTG + cb_ + (size_t)dv0 * 64 + (size_t)(lane + 64 * q) * 8); \
        gl = gcG[(size_t)(s * 128 + (n_)) * 64 + 63]; } while (0)
    G2L_LOAD(0);
    for (int n = 0; n < 128; ++n) { const size_t cb = (size_t)(s * 128 + n) * 4096;
#pragma unroll
        for (int q = 0; q < 8; ++q) { const int piece = lane + 64 * q; *(u32x4*)(Lw + (piece >> 3) * 72 + (piece & 7) * 8) = rw[q]; *(u32x4*)(Lk + (piece >> 3) * 72 + (piece & 7) * 8) = rk[q]; }
#pragma unroll
        for (int q = 0; q < 2; ++q) { const int piece = lane + 64 * q; *(u32x4*)(Lu + (piece >> 3) * 72 + (piece & 7) * 8) = ru[q]; }
        const float eg = __expf(gl);
        __builtin_amdgcn_sched_barrier(0);
        { const int n1 = n + 1 < 128 ? n + 1 : 127; G2L_LOAD(n1); }
        __builtin_amdgcn_sched_barrier(0);
        f32x4 acc[4];
#pragma unroll
        for (int mt = 0; mt < 4; ++mt) { const u32x2 uu = *(const u32x2*)(Lu + r16 * 72 + 16 * mt + 4 * g); acc[mt] = (f32x4){bflo(uu.x), bfhi(uu.x), bflo(uu.y), bfhi(uu.y)}; }
#pragma unroll
        for (int mt = 0; mt < 4; ++mt) { u32x2 w; w.x = cvtpk(S[mt][0], S[mt][1]); w.y = cvtpk(S[mt][2], S[mt][3]); *(u32x2*)(ST + cb + (dv0 + r16) * 64 + 16 * mt + 4 * g) = w; }
        bf16x8 Bs[2];
#pragma unroll
        for (int ks = 0; ks < 2; ++ks) Bs[ks] = __builtin_bit_cast(bf16x8, pack8(-S[2 * ks], -S[2 * ks + 1]));
#pragma unroll
        for (int mt = 0; mt < 4; ++mt)
#pragma unroll
            for (int ks = 0; ks < 2; ++ks) acc[mt] = MFMA16(ld2x8(Lw + (16 * mt + r16) * 72 + 32 * ks + 4 * g, Lw + (16 * mt + r16) * 72 + 32 * ks + 16 + 4 * g), Bs[ks], acc[mt]);
#pragma unroll
        for (int mt = 0; mt < 4; ++mt) { u32x2 w; w.x = cvtpk(acc[mt][0], acc[mt][1]); w.y = cvtpk(acc[mt][2], acc[mt][3]); *(u32x2*)(vnT + cb + (dv0 + r16) * 64 + 16 * mt + 4 * g) = w; }
        bf16x8 Bv[2];
#pragma unroll
        for (int ks = 0; ks < 2; ++ks) Bv[ks] = __builtin_bit_cast(bf16x8, pack8(acc[2 * ks], acc[2 * ks + 1]));
#pragma unroll
        for (int mt = 0; mt < 4; ++mt) { S[mt] = S[mt] * eg;
#pragma unroll
            for (int ks = 0; ks < 2; ++ks) S[mt] = MFMA16(ld2x8(Lk + (16 * mt + r16) * 72 + 32 * ks + 4 * g, Lk + (16 * mt + r16) * 72 + 32 * ks + 16 + 4 * g), Bv[ks], S[mt]); }
        __builtin_amdgcn_sched_barrier(0);
    }
#undef G2L_LOAD
#pragma unroll
    for (int mt = 0; mt < 4; ++mt)
#pragma unroll
        for (int r = 0; r < 4; ++r) s_out[(16 * mt + 4 * g + r) * 64 + dv0 + r16] = S[mt][r];
}

__device__ __forceinline__ void phase3(KP p, unsigned char* lds, const int mk_wid) {
    using bf16 = attn_body::bf16;
    const int wid = mk_wid, tid = mk_tid(mk_wid), lane = tid & 63, bid = blockIdx.x;
    const int G = (int)gridDim.x;
    if (wid == 0) for (int task = bid; task < 128; task += G) { const int s = task >> 2; g2_scan_lds(p, s, 16 * (task & 3), p->out + O_SGP + (size_t)s * 4096, lane, lds); }
    { const int sb0 = G >= 192 ? 128 : 0;
      if (bid >= sb0) for (int wt = (bid - sb0) * 8 + wid; wt < 512; wt += (G - sb0) * 8) { const int s = wt >> 2; g2_task(p, 4096 + s, 1, 16 * (wt & 3), p->in[5] + (size_t)s * 4096, p->out + O_SGS + (size_t)s * 4096, lane); } }
    __syncthreads();
    unsigned* ctr = (unsigned*)(p->ws + WS_CTL);
    volatile int* sidx = (volatile int*)(lds + 120000);
    bf16* QP = (bf16*)(p->ws + WS_QP); const bf16* KP = (const bf16*)(p->ws + WS_KP); const bf16* VP = (const bf16*)(p->ws + WS_VP);
    const bf16* QS = (const bf16*)(p->ws + WS_QS); const bf16* KS = (const bf16*)(p->ws + WS_KS); const bf16* VS = (const bf16*)(p->ws + WS_VS);
    for (;;) {
        if (tid == 0) *sidx = (int)atomicAdd(ctr, 1u);
        __syncthreads(); const int idx = __builtin_amdgcn_readfirstlane(*sidx); __syncthreads();
        if (idx >= 1152) break;
        {
            int q0, nvalid; const bf16 *Qu, *Kh, *Vh; bf16* Ou; const float* G;
            int nidx;
            if (idx < 1024) { const int qb = 31 - (idx >> 5), bh = idx & 31, b = bh >> 3, h = bh & 7; q0 = qb * 256; nvalid = 256; nidx = bh;
                Ou = QP + ((size_t)(b * SEQ + q0) * 512 + h * 64); Qu = Ou; Kh = KP + ((size_t)b * SEQ * 512 + h * 64); Vh = VP + ((size_t)b * SEQ * 512 + h * 64); G = (const float*)(p->ws + WS_GCP) + (size_t)bh * SEQ; }
            else { const int bh = idx - 1024, b = bh >> 3, h = bh & 7; q0 = PAST; nvalid = 16; nidx = 32 + bh;
                Qu = QS + ((size_t)(b * 256) * 512 + h * 64); Kh = KS + ((size_t)b * SKV * 512 + h * 64); Vh = VS + ((size_t)b * SKV * 512 + h * 64);
                Ou = QP + ((size_t)(NPROMPT + b * 16) * 512 + h * 64); G = (const float*)(p->ws + WS_GCS) + (size_t)bh * SKV; }
            { const float* NR = (const float*)(p->ws + WS_CTL) + 512 + nidx * 2; const float thr = 41.0f + 2.02f * sqrtf(NR[0] * NR[1]);
              const int NTt = (q0 + 256) >> 6, tc = 2 * lane; const float gq = G[q0];
              bool ok = tc <= NTt - 4; if (ok && tc > 0) ok = (gq - G[64 * tc - 1]) * 1.4426950408889634f <= -thr;
              const unsigned long long mk = __ballot(ok); const int cnt = __builtin_amdgcn_readfirstlane((int)__ffsll((long long)~mk) - 1);
              const int t0 = 2 * (cnt > 0 ? cnt - 1 : 0);
              attn_body::attn_unit<60>(q0 - 64 * t0, nvalid, Qu, Kh + (size_t)t0 * 64 * 512, Vh + (size_t)t0 * 64 * 512, Ou, G + 64 * t0, (char*)lds, mk_wid); }
        }
    }
}

__device__ __forceinline__ void g3_task(KP p, int cid, int ib, int rowbase, int h, int lane) {
    const int g = lane >> 4, r16 = lane & 15, i = 16 * ib + r16; const size_t cb = (size_t)cid * 4096;
    const bf16_t* qG = (const bf16_t*)(p->ws + WS_QG) + cb; const bf16_t* kG = (const bf16_t*)(p->ws + WS_KG) + cb; const bf16_t* vnT = (const bf16_t*)(p->ws + WS_VNT) + cb; const bf16_t* ST = (const bf16_t*)(p->ws + WS_ST) + cb;
    const float* gc = (const float*)(p->ws + WS_GCG) + (size_t)cid * 64;
    bf16x8 Bq[2], Akk[4][2], Ast[4][2], Avn[4][2]; f32x4 gj[4];
#pragma unroll
    for (int ks = 0; ks < 2; ++ks) Bq[ks] = *(const bf16x8*)(qG + i * 64 + 32 * ks + 8 * g);
    const float gci = gc[i];
#pragma unroll
    for (int t4 = 0; t4 < 4; ++t4) { gj[t4] = *(const f32x4*)(gc + 16 * t4 + 4 * g);
#pragma unroll
        for (int ks = 0; ks < 2; ++ks) { Akk[t4][ks] = *(const bf16x8*)(kG + (16 * t4 + r16) * 64 + 32 * ks + 8 * g); Ast[t4][ks] = *(const bf16x8*)(ST + (16 * t4 + r16) * 64 + 32 * ks + 8 * g);
            Avn[t4][ks] = ld2x8(vnT + (16 * t4 + r16) * 64 + 32 * ks + 4 * g, vnT + (16 * t4 + r16) * 64 + 32 * ks + 16 + 4 * g); } }
    const size_t R = (size_t)(rowbase + i);
    const bf16_t* GG = (const bf16_t*)(p->ws + WS_GG) + R * 512 + h * 64; bf16_t* OG = (bf16_t*)(p->ws + WS_OG) + R * 512 + h * 64;
    u32x2 gw[4]; f32x4 ng[4];
#pragma unroll
    for (int mt = 0; mt < 4; ++mt) { gw[mt] = *(const u32x2*)(GG + 16 * mt + 4 * g); ng[mt] = *(const f32x4*)(p->in[12] + 16 * mt + 4 * g); }
    __builtin_amdgcn_sched_barrier(0);
    f32x4 P[4];
#pragma unroll
    for (int jt = 0; jt < 4; ++jt) { f32x4 acc = {0.f, 0.f, 0.f, 0.f};
#pragma unroll
        for (int ks = 0; ks < 2; ++ks) acc = MFMA16(Akk[jt][ks], Bq[ks], acc);
#pragma unroll
        for (int r = 0; r < 4; ++r) { const int j = 16 * jt + 4 * g + r; P[jt][r] = (j <= i) ? acc[r] * __expf(gci - gj[jt][r]) : 0.f; } }
    bf16x8 Bp[2];
#pragma unroll
    for (int ks = 0; ks < 2; ++ks) Bp[ks] = __builtin_bit_cast(bf16x8, pack8(P[2 * ks], P[2 * ks + 1]));
    const float egi = __expf(gci);
    f32x4 o[4]; float ss = 0.f;
#pragma unroll
    for (int mt = 0; mt < 4; ++mt) { f32x4 acc = {0.f, 0.f, 0.f, 0.f};
#pragma unroll
        for (int ks = 0; ks < 2; ++ks) acc = MFMA16(Ast[mt][ks], Bq[ks], acc);
        acc = acc * egi;
#pragma unroll
        for (int ks = 0; ks < 2; ++ks) acc = MFMA16(Avn[mt][ks], Bp[ks], acc);
        o[mt] = acc; ss += acc[0] * acc[0] + acc[1] * acc[1] + acc[2] * acc[2] + acc[3] * acc[3]; }
    ss += __shfl_xor(ss, 16); ss += __shfl_xor(ss, 32);
    const float rs = rsqrtf(ss * (1.0f / 64.0f) + EPS);
#pragma unroll
    for (int mt = 0; mt < 4; ++mt) {
        const float z0 = bflo(gw[mt].x), z1 = bfhi(gw[mt].x), z2 = bflo(gw[mt].y), z3 = bfhi(gw[mt].y);
        u32x2 w; w.x = cvtpk(o[mt][0] * rs * ng[mt][0] * z0 * sigmoidf_(z0), o[mt][1] * rs * ng[mt][1] * z1 * sigmoidf_(z1)); w.y = cvtpk(o[mt][2] * rs * ng[mt][2] * z2 * sigmoidf_(z2), o[mt][3] * rs * ng[mt][3] * z3 * sigmoidf_(z3));
        *(u32x2*)(OG + 16 * mt + 4 * g) = w; }
}
__device__ __forceinline__ void phase4(KP p, unsigned char* lds, const int mk_wid) {
    const int wid = mk_wid, tid = mk_tid(mk_wid), lane = tid & 63;
    const int half = wid >> 2, ib = wid & 3, t256 = tid & 255, g = lane >> 4, r16 = lane & 15;
    bf16_t* L = (bf16_t*)lds + half * (4 * 64 * 72);
    const bf16_t* Lq = L; const bf16_t* Lk = L + 64 * 72; const bf16_t* Ls = L + 2 * 64 * 72; const bf16_t* Lv = L + 3 * 64 * 72;
    u32x4 v[4][2];
#define G3_LOADV(pr_) do { const size_t cb_ = (size_t)(2 * (pr_) + half) * 4096; \
        const bf16_t* src_[4] = {(const bf16_t*)(p->ws + WS_QG) + cb_, (const bf16_t*)(p->ws + WS_KG) + cb_, (const bf16_t*)(p->ws + WS_ST) + cb_, (const bf16_t*)(p->ws + WS_VNT) + cb_}; \
        _Pragma("unroll") for (int a = 0; a < 4; ++a) _Pragma("unroll") for (int q = 0; q < 2; ++q) v[a][q] = *(const u32x4*)(src_[a] + (size_t)(t256 + 256 * q) * 8); } while (0)
    if ((int)blockIdx.x < 2112) G3_LOADV((int)blockIdx.x);
    for (int pr = blockIdx.x; pr < 2112; pr += gridDim.x) {
        const int cid = 2 * pr + half; const bool samp = cid >= 4096;
        const int bh = samp ? cid - 4096 : cid >> 7, h = bh & 7;
        const int rowbase = samp ? NPROMPT + (bh >> 3) * 16 : (bh >> 3) * SEQ + 64 * (cid & 127);
#pragma unroll
        for (int a = 0; a < 4; ++a)
#pragma unroll
            for (int q = 0; q < 2; ++q) { const int piece = t256 + 256 * q; *(u32x4*)(L + (a * 64 + (piece >> 3)) * 72 + (piece & 7) * 8) = v[a][q]; }
        __syncthreads();
        if (pr + (int)gridDim.x < 2112) G3_LOADV(pr + (int)gridDim.x);
        __builtin_amdgcn_sched_barrier(0);
        if (!samp || ib == 0) {
            const int i = 16 * ib + r16;
            const float* gc = (const float*)(p->ws + WS_GCG) + (size_t)cid * 64;
            const size_t R = (size_t)(rowbase + i);
            const bf16_t* GG = (const bf16_t*)(p->ws + WS_GG) + R * 512 + h * 64; bf16_t* OG = (bf16_t*)(p->ws + WS_OG) + R * 512 + h * 64;
            const float gci = gc[i]; f32x4 gj[4]; u32x2 gw[4]; f32x4 ng[4];
#pragma unroll
            for (int t4 = 0; t4 < 4; ++t4) { gj[t4] = *(const f32x4*)(gc + 16 * t4 + 4 * g); gw[t4] = *(const u32x2*)(GG + 16 * t4 + 4 * g); ng[t4] = *(const f32x4*)(p->in[12] + 16 * t4 + 4 * g); }
            bf16x8 Bq[2];
#pragma unroll
            for (int ks = 0; ks < 2; ++ks) Bq[ks] = *(const bf16x8*)(Lq + i * 72 + 32 * ks + 8 * g);
            f32x4 P[4];
#pragma unroll
            for (int jt = 0; jt < 4; ++jt) { f32x4 acc = {0.f, 0.f, 0.f, 0.f};
#pragma unroll
                for (int ks = 0; ks < 2; ++ks) acc = MFMA16(*(const bf16x8*)(Lk + (16 * jt + r16) * 72 + 32 * ks + 8 * g), Bq[ks], acc);
#pragma unroll
                for (int r = 0; r < 4; ++r) { const int j = 16 * jt + 4 * g + r; P[jt][r] = (j <= i) ? acc[r] * __expf(gci - gj[jt][r]) : 0.f; } }
            bf16x8 Bp[2];
#pragma unroll
            for (int ks = 0; ks < 2; ++ks) Bp[ks] = __builtin_bit_cast(bf16x8, pack8(P[2 * ks], P[2 * ks + 1]));
            const float egi = __expf(gci);
            f32x4 o[4]; float ss = 0.f;
#pragma unroll
            for (int mt = 0; mt < 4; ++mt) { f32x4 acc = {0.f, 0.f, 0.f, 0.f};
#pragma unroll
                for (int ks = 0; ks < 2; ++ks) acc = MFMA16(*(const bf16x8*)(Ls + (16 * mt + r16) * 72 + 32 * ks + 8 * g), Bq[ks], acc);
                acc = acc * egi;
#pragma unroll
                for (int ks = 0; ks < 2; ++ks) acc = MFMA16(ld2x8(Lv + (16 * mt + r16) * 72 + 32 * ks + 4 * g, Lv + (16 * mt + r16) * 72 + 32 * ks + 16 + 4 * g), Bp[ks], acc);
                o[mt] = acc; ss += acc[0] * acc[0] + acc[1] * acc[1] + acc[2] * acc[2] + acc[3] * acc[3]; }
            ss += __shfl_xor(ss, 16); ss += __shfl_xor(ss, 32);
            const float rs = rsqrtf(ss * (1.0f / 64.0f) + EPS);
#pragma unroll
            for (int mt = 0; mt < 4; ++mt) {
                const float z0 = bflo(gw[mt].x), z1 = bfhi(gw[mt].x), z2 = bflo(gw[mt].y), z3 = bfhi(gw[mt].y);
                u32x2 w; w.x = cvtpk(o[mt][0] * rs * ng[mt][0] * z0 * sigmoidf_(z0), o[mt][1] * rs * ng[mt][1] * z1 * sigmoidf_(z1)); w.y = cvtpk(o[mt][2] * rs * ng[mt][2] * z2 * sigmoidf_(z2), o[mt][3] * rs * ng[mt][3] * z3 * sigmoidf_(z3));
                *(u32x2*)(OG + 16 * mt + 4 * g) = w; }
        }
        __syncthreads();
    }
#undef G3_LOADV
}

__device__ __forceinline__ void phase7(KP p, const int mk_wid) {
    const int wid = mk_wid, tid = mk_tid(mk_wid), lane = tid & 63;
    const float* MIX = (const float*)(p->ws + WS_MIX); const float* RS1 = (const float*)(p->ws + WS_RS1); bf16_t* XN2 = (bf16_t*)(p->ws + WS_XN2);
    const int rstep = gridDim.x * 8;
    for (int rowa = blockIdx.x * 8 + wid; rowa < NPROMPT; rowa += 2 * rstep) {
        int rows[2]; rows[0] = rowa; rows[1] = rowa + rstep < NPROMPT ? rowa + rstep : rowa;
        f32x4 xv[2][4], mv[2][4]; float q1[2];
#pragma unroll
        for (int q = 0; q < 2; ++q) { const int row = rows[q]; const float* xr = p->in[0] + (size_t)row * 1024;
            q1[q] = RS1[(size_t)row * 16 + (lane & 15)];
#pragma unroll
            for (int i = 0; i < 4; ++i) { const int c = lane * 4 + 256 * i; xv[q][i] = __builtin_nontemporal_load((const f32x4*)(xr + c)); const u32x2 mw = __builtin_nontemporal_load((const u32x2*)((const bf16_t*)MIX + (size_t)row * 1024 + c)); mv[q][i] = (f32x4){bflo(mw.x), bfhi(mw.x), bflo(mw.y), bfhi(mw.y)}; } }
        __builtin_amdgcn_sched_barrier(0);
#pragma unroll
        for (int q = 0; q < 2; ++q) { const int row = rows[q]; float qq = q1[q]; qq += __shfl_xor(qq, 8); qq += __shfl_xor(qq, 4); qq += __shfl_xor(qq, 2); qq += __shfl_xor(qq, 1);
            const float rs1 = rsqrtf(qq * (1.0f / 1024.0f) + EPS);
            f32x4 v[4]; float ss = 0.f;
#pragma unroll
            for (int i = 0; i < 4; ++i) { const int c = lane * 4 + 256 * i; const f32x4 g = *(const f32x4*)(p->in[17] + c);
                v[i] = xv[q][i] + mv[q][i] * rs1 * g; ss += v[i][0] * v[i][0] + v[i][1] * v[i][1] + v[i][2] * v[i][2] + v[i][3] * v[i][3];
                *(f32x4*)(p->out + O_Y + (size_t)row * 1024 + c) = v[i]; }
            ss = wave_sum(ss); const float rs2 = rsqrtf(ss * (1.0f / 1024.0f) + EPS);
#pragma unroll
            for (int i = 0; i < 4; ++i) { const int c = lane * 4 + 256 * i; const f32x4 g = *(const f32x4*)(p->in[18] + c); const f32x4 y = v[i] * rs2 * g;
                u32x2 w; w.x = cvtpk(y[0], y[1]); w.y = cvtpk(y[2], y[3]); *(u32x2*)(XN2 + (size_t)row * 1024 + c) = w; } } }
    { const float* MP = (const float*)(p->ws + WS_DOWNP);
      for (int sr = blockIdx.x * 8 + wid; sr < NSAMP; sr += rstep) { f32x4 m[4]; float qq = 0.f;
#pragma unroll
          for (int i = 0; i < 4; ++i) { const size_t o = (size_t)sr * 1024 + lane * 4 + 256 * i;
              m[i] = ((*(const f32x4*)(MP + o) + *(const f32x4*)(MP + 262144 + o)) + *(const f32x4*)(MP + 2 * 262144 + o)) + *(const f32x4*)(MP + 3 * 262144 + o);
              qq += m[i][0] * m[i][0] + m[i][1] * m[i][1] + m[i][2] * m[i][2] + m[i][3] * m[i][3]; }
          qq = wave_sum(qq); const float rs1 = rsqrtf(qq * (1.0f / 1024.0f) + EPS); const int row = NPROMPT + sr;
          f32x4 v[4]; float ss = 0.f;
#pragma unroll
          for (int i = 0; i < 4; ++i) { const int c = lane * 4 + 256 * i; const f32x4 x = *(const f32x4*)(p->in[1] + (size_t)sr * 1024 + c), g = *(const f32x4*)(p->in[17] + c);
              v[i] = x + m[i] * rs1 * g; ss += v[i][0] * v[i][0] + v[i][1] * v[i][1] + v[i][2] * v[i][2] + v[i][3] * v[i][3];
              *(f32x4*)(p->out + O_Y + (size_t)row * 1024 + c) = v[i]; }
          ss = wave_sum(ss); const float rs2 = rsqrtf(ss * (1.0f / 1024.0f) + EPS);
#pragma unroll
          for (int i = 0; i < 4; ++i) { const int c = lane * 4 + 256 * i; const f32x4 g = *(const f32x4*)(p->in[18] + c); const f32x4 y = v[i] * rs2 * g;
              u32x2 w; w.x = cvtpk(y[0], y[1]); w.y = cvtpk(y[2], y[3]); *(u32x2*)(XN2 + (size_t)row * 1024 + c) = w; } } }
}
__device__ __forceinline__ void phase10(KP p, const int mk_wid) {
    const int wid = mk_wid, tid = mk_tid(mk_wid), lane = tid & 63;
    const float* DN = (const float*)(p->ws + WS_DOWN); const float* RS2 = (const float*)(p->ws + WS_RS2); const float* DP = (const float*)(p->ws + WS_DOWNP);
    const int rstep = gridDim.x * 8;
    for (int rowa = blockIdx.x * 8 + wid; rowa < NPROMPT; rowa += 2 * rstep) {
        const int nr = rowa + rstep < NPROMPT ? 2 : 1;
        f32x4 xv[2][4], dv[2][4]; float q2[2];
#pragma unroll
        for (int q = 0; q < 2; ++q) { const int row = q < nr ? rowa + q * rstep : rowa; q2[q] = RS2[(size_t)row * 16 + (lane & 15)];
#pragma unroll
            for (int i = 0; i < 4; ++i) { const int c = lane * 4 + 256 * i; xv[q][i] = __builtin_nontemporal_load((const f32x4*)(p->out + O_Y + (size_t)row * 1024 + c)); const u32x2 dw = __builtin_nontemporal_load((const u32x2*)((const bf16_t*)DN + (size_t)row * 1024 + c)); dv[q][i] = (f32x4){bflo(dw.x), bfhi(dw.x), bflo(dw.y), bfhi(dw.y)}; } }
        __builtin_amdgcn_sched_barrier(0);
#pragma unroll
        for (int q = 0; q < 2; ++q) if (q < nr) { const int row = rowa + q * rstep; float qq = q2[q]; qq += __shfl_xor(qq, 8); qq += __shfl_xor(qq, 4); qq += __shfl_xor(qq, 2); qq += __shfl_xor(qq, 1);
            const float rs = rsqrtf(qq * (1.0f / 1024.0f) + EPS);
#pragma unroll
            for (int i = 0; i < 4; ++i) { const int c = lane * 4 + 256 * i; const f32x4 g = *(const f32x4*)(p->in[19] + c);
                __builtin_nontemporal_store(xv[q][i] + dv[q][i] * rs * g, (f32x4*)(p->out + O_Y + (size_t)row * 1024 + c)); } } }
    for (int sr = blockIdx.x * 8 + wid; sr < NSAMP; sr += rstep) { f32x4 d[4]; float ss = 0.f;
#pragma unroll
        for (int i = 0; i < 4; ++i) { const int c = lane * 4 + 256 * i; const size_t o = (size_t)sr * 1024 + c;
            d[i] = ((*(const f32x4*)(DP + o) + *(const f32x4*)(DP + 262144 + o)) + *(const f32x4*)(DP + 2 * 262144 + o)) + *(const f32x4*)(DP + 3 * 262144 + o);
            ss += d[i][0] * d[i][0] + d[i][1] * d[i][1] + d[i][2] * d[i][2] + d[i][3] * d[i][3]; }
        ss = wave_sum(ss); const float rs = rsqrtf(ss * (1.0f / 1024.0f) + EPS);
#pragma unroll
        for (int i = 0; i < 4; ++i) { const int c = lane * 4 + 256 * i; float* yp = p->out + O_Y + (size_t)(NPROMPT + sr) * 1024 + c; const f32x4 g = *(const f32x4*)(p->in[19] + c);
            *(f32x4*)yp = *(const f32x4*)yp + d[i] * rs * g; } }
}

__device__ __forceinline__ void gbar(unsigned* cnt, unsigned nblocks, const int mk_wid) {
    __syncthreads();
    if (mk_tid(mk_wid) == 0) {
        __builtin_amdgcn_fence(__ATOMIC_RELEASE, "agent");
        const unsigned grp = blockIdx.x & 7u, gsize = (nblocks + 7u - grp) >> 3, ngrp = nblocks < 8u ? nblocks : 8u;
        if (__hip_atomic_fetch_add(cnt + 32u * (grp + 1u), 1u, __ATOMIC_RELAXED, __HIP_MEMORY_SCOPE_AGENT) + 1u == gsize) {
            __builtin_amdgcn_fence(__ATOMIC_SEQ_CST, "agent");
            __hip_atomic_fetch_add(cnt, 1u, __ATOMIC_RELAXED, __HIP_MEMORY_SCOPE_AGENT);
        }
        while (__hip_atomic_load(cnt, __ATOMIC_RELAXED, __HIP_MEMORY_SCOPE_AGENT) < ngrp) __builtin_amdgcn_s_sleep(1);
        __builtin_amdgcn_fence(__ATOMIC_ACQUIRE, "agent");
    }
    __syncthreads();
}
__global__ void __launch_bounds__(512, 2) mega(Params p_unused) {
    extern __shared__ __attribute__((aligned(16))) unsigned char lds[];
    KP p = (KP)__builtin_amdgcn_kernarg_segment_ptr();
#define FRESH() asm volatile("" : "+s"(p))
    cg::grid_group grid = cg::this_grid();
    PG8_LAS unsigned char* lds3 = (PG8_LAS unsigned char*)lds;
    const int mk_wid = __builtin_amdgcn_readfirstlane((int)(threadIdx.x >> 6));
    const int G = (int)gridDim.x, bid = (int)blockIdx.x; const int ph_lo = p->ph_lo, ph_hi = p->ph_hi;
#define IN(k) (ph_lo <= (k) && (k) < ph_hi)
#define SEAM(k) do { if ((k) + 1 < ph_hi) { if ((k) == 0) grid.sync(); else gbar((unsigned*)(p->ws + WS_BAR) + 512 * ((k) + 16 * rep_), (unsigned)G, mk_wid); } FRESH(); } while (0)
#ifndef MK_DUP
#define MK_DUP (-1)
#endif
#define REPS(k) for (int rep_ = 0; rep_ < ((MK_DUP) == (k) ? 2 : 1); ++rep_)
    if (IN(0)) REPS(0) { phase0(p, lds, mk_wid); SEAM(0); }
    if (IN(1)) REPS(1) {
        pg8::Gemm g{(const pg8::bf16_t*)(p->ws + WS_XN), (const pg8::bf16_t*)(p->ws + WS_WIN), MROWS, NZ, DMODEL, DMODEL}; pg8::StaticOrder S; S.init(MROWS, NZ, G, bid);
        EpiIn E{p->out, p->ws, p->in[8], p->in[10], p->in[11]};
        pg8::gemm_phase<EpiIn, pg8::StaticOrder, true, true>(lds3, g, S, E, mk_wid);
        SEAM(1);
    }
    if (IN(2)) REPS(2) {
        for (int u = bid; u < 20 + 272 + 1056; u += G) { if (u < 20) cumsum_unit(p, u, lds, mk_wid); else if (u < 292) norm_unit(p, u - 20, mk_wid); else g1_unit(p, u - 292, lds, mk_wid); }
        SEAM(2);
    }
    if (IN(3)) REPS(3) { phase3(p, lds, mk_wid); SEAM(3); }
    if (IN(4)) REPS(4) { phase4(p, lds, mk_wid); SEAM(4); }
    if (IN(5)) REPS(5) {
        { pg8::Gemm g{(const pg8::bf16_t*)(p->ws + WS_QP), (const pg8::bf16_t*)(p->ws + WS_WPA), MROWS, DMODEL, 512, 512}; pg8::StaticOrder S; S.init(MROWS, DMODEL, G, bid);
          EpiBf<0> E{p->out, p->ws}; pg8::gemm_phase<EpiBf<0>, pg8::StaticOrder, true, true>(lds3, g, S, E, mk_wid); }
        __syncthreads();
        { pg8::Gemm g{(const pg8::bf16_t*)(p->ws + WS_OG), (const pg8::bf16_t*)(p->ws + WS_WPB), MROWS, DMODEL, 512, 512}; pg8::StaticOrder S; S.init(MROWS, DMODEL, G, bid);
          EpiBf<1> E{p->out, p->ws}; pg8::gemm_phase<EpiBf<1>, pg8::StaticOrder, true, true>(lds3, g, S, E, mk_wid); }
        SEAM(5);
    }
    if (IN(6)) REPS(6) {
        { pg8::Gemm g{(const pg8::bf16_t*)(p->ws + WS_MB), (const pg8::bf16_t*)(p->ws + WS_WOUT), NPROMPT, DMODEL, DMODEL, DMODEL}; pg8::StaticOrder S; S.init(NPROMPT, DMODEL, G, bid);
          EpiF32SS E{(float*)(p->ws + WS_MIX), (float*)(p->ws + WS_RS1)};
          pg8::gemm_phase<EpiF32SS, pg8::StaticOrder, true, true>(lds3, g, S, E, mk_wid); }
        __syncthreads();
        { const int ks = (bid >> 2) & 3;
          pg8::Gemm g{(const pg8::bf16_t*)(p->ws + WS_MB) + ks * 256, (const pg8::bf16_t*)(p->ws + WS_WOUT) + ks * 256, MROWS, DMODEL, 256, DMODEL}; SplitOrder S{bid};
          EpiPart E{(float*)(p->ws + WS_DOWNP) + (size_t)ks * 262144};
          pg8::gemm_phase<EpiPart, SplitOrder, true, true>(lds3, g, S, E, mk_wid); }
        SEAM(6);
    }
    if (IN(7)) REPS(7) { phase7(p, mk_wid); SEAM(7); }
    if (IN(8)) REPS(8) {
        pg8::Gemm g{(const pg8::bf16_t*)(p->ws + WS_XN2), (const pg8::bf16_t*)(p->ws + WS_WUP), MROWS, DFF, DMODEL, DMODEL}; pg8::StaticOrder S; S.init(MROWS, DFF, G, bid);
        EpiBf<2> E{p->out, p->ws}; pg8::gemm_phase<EpiBf<2>, pg8::StaticOrder, true, true>(lds3, g, S, E, mk_wid);
        SEAM(8);
    }
    if (IN(9)) REPS(9) {
        { pg8::Gemm g{(const pg8::bf16_t*)(p->ws + WS_H), (const pg8::bf16_t*)(p->ws + WS_WDN), NPROMPT, DMODEL, DFF, DFF}; pg8::StaticOrder S; S.init(NPROMPT, DMODEL, G, bid);
          EpiF32SS E{(float*)(p->ws + WS_DOWN), (float*)(p->ws + WS_RS2)};
          pg8::gemm_phase<EpiF32SS, pg8::StaticOrder, true, true>(lds3, g, S, E, mk_wid); }
        __syncthreads();
        { const int ks = (bid >> 2) & 3;
          pg8::Gemm g{(const pg8::bf16_t*)(p->ws + WS_H) + ks * 1024, (const pg8::bf16_t*)(p->ws + WS_WDN) + ks * 1024, MROWS, DMODEL, 1024, DFF}; SplitOrder S{bid};
          EpiPart E{(float*)(p->ws + WS_DOWNP) + (size_t)ks * 262144};
          pg8::gemm_phase<EpiPart, SplitOrder, true, true>(lds3, g, S, E, mk_wid); }
        SEAM(9);
    }
    if (IN(10)) REPS(10) { phase10(p, mk_wid); }
#if defined(MK_DUMP_OFF)
#ifndef MK_AMP
#define MK_AMP(v) (v)
#endif
    if (IN(99)) { const bf16_t* src = (const bf16_t*)(p->ws + (size_t)(MK_DUMP_OFF)); const int tid = mk_tid(mk_wid);
        for (size_t e = (size_t)bid * 512 + tid; e < (size_t)MROWS * 1024; e += (size_t)G * 512) { const size_t row = e >> 10; const int c = (int)(e & 1023);
#if defined(MK_DUMP_F32)
            p->out[O_Y + e] = MK_AMP(((const float*)src)[e]); } }
#else
            p->out[O_Y + e] = c < (MK_DUMP_W) ? MK_AMP(bf2f(src[row * (MK_DUMP_W) + c])) : 0.f; } }
#endif
#endif
#undef IN
#undef SEAM
}
}

extern "C" void kernel_launch(void* const* d_in, const int* in_sizes, int n_in, void* d_out, int out_size, void* d_ws, size_t ws_size, hipStream_t stream) {
    using namespace mk;
    static int grid = 0;
    if (grid == 0) {
        if (n_in != 22 || (size_t)out_size != O_END || ws_size < WS_END) { fprintf(stderr, "kernel_launch: unexpected shapes: n_in %d out %d ws %zu (need %zu)\n", n_in, out_size, ws_size, (size_t)WS_END); grid = -1; return; }
        int dev = 0, cus = 0, per_cu = 0;
        if (hipGetDevice(&dev) != hipSuccess || hipDeviceGetAttribute(&cus, hipDeviceAttributeMultiprocessorCount, dev) != hipSuccess) { grid = -1; return; }
        if (hipFuncSetAttribute((const void*)mega, hipFuncAttributeMaxDynamicSharedMemorySize, LDS_BYTES) != hipSuccess) { fprintf(stderr, "kernel_launch: hipFuncSetAttribute failed\n"); grid = -1; return; }
        if (hipOccupancyMaxActiveBlocksPerMultiprocessor(&per_cu, (const void*)mega, 512, LDS_BYTES) != hipSuccess || per_cu < 1) { fprintf(stderr, "kernel_launch: occupancy query failed (%d)\n", per_cu); (void)hipGetLastError(); per_cu = 1; }
        grid = cus * 1;
    }
    if (grid < 0) return;
    (void)hipMemsetAsync((unsigned char*)d_ws + WS_BAR, 0, 65536, stream);
    Params p{};
    for (int i = 0; i < 22; ++i) p.in[i] = (const float*)d_in[i];
    p.out = (float*)d_out; p.ws = (unsigned char*)d_ws;
#if MK_PER_PHASE
    for (int ph = 0; ph < MK_PH_MAX; ++ph) { p.ph_lo = ph; p.ph_hi = ph + 1; hipLaunchKernelGGL(mega, dim3(grid), dim3(512), LDS_BYTES, stream, p); }
#if defined(MK_DUMP_OFF)
    p.ph_lo = 99; p.ph_hi = 100; hipLaunchKernelGGL(mega, dim3(grid), dim3(512), LDS_BYTES, stream, p);
#endif
#else
    p.ph_lo = 0; p.ph_hi = 11;
    void* args[] = {&p};
    hipError_t e = hipLaunchCooperativeKernel((const void*)mega, dim3(grid), dim3(512), args, LDS_BYTES, stream);
    if (e != hipSuccess) fprintf(stderr, "kernel_launch: cooperative launch failed: %s (grid %d)\n", hipGetErrorString(e), grid);
#endif
}
```

```cpp
#include <hip/hip_runtime.h>
#include <hip/hip_cooperative_groups.h>
#include <hip/hip_bf16.h>
#include <cstdio>
#include <cstdint>
#include <cmath>
namespace cg = cooperative_groups;
#ifndef MK_PH_MAX
#define MK_PH_MAX 11
#endif
#ifndef MK_PER_PHASE
#define MK_PER_PHASE 0
#endif
__device__ __forceinline__ int mk_tid(int wid_s) { return wid_s * 64 + (int)__builtin_amdgcn_mbcnt_hi(~0u, __builtin_amdgcn_mbcnt_lo(~0u, 0u)); }
namespace pg8 {
#define PG8_LAS __attribute__((address_space(3)))
typedef unsigned short bf16_t;
typedef short bf16x8 __attribute__((ext_vector_type(8)));
typedef float f32x4 __attribute__((ext_vector_type(4)));
typedef unsigned u32x4 __attribute__((ext_vector_type(4)));
constexpr int BM = 256, BK = 64, HALF = 128, HTB = HALF * BK * 2  , STAGE_BYTES = 8 * HTB, NXCD = 8, WGM = 8;

__host__ __device__ __forceinline__ int lds_byte(int r, int c) { const int st = (r >> 4) * 2 + (c >> 5), rr = r & 15, cc = c & 31, ob = rr * 64 + cc * 2; return st * 1024 + (ob ^ (((ob >> 9) & 1) << 5)); }
__host__ __device__ __forceinline__ void stage_rc(int b, int& R, int& C) { const int st = b / 1024, sb = b % 1024, swz = sb ^ (((sb >> 9) & 1) << 5); R = (st >> 1) * 16 + swz / 64; C = (st & 1) * 32 + (swz % 64) / 2; }
__host__ __device__ __forceinline__ int perm32(int rho) { const int n = rho >> 4, i = rho & 15; return 8 * (i >> 2) + 4 * n + (i & 3); }

struct Unit { int pm, pn; };
struct Gemm { const bf16_t* A; const bf16_t* Bt; int M, N, K, ld; };

struct StaticOrder {
    int nM, nN, nwg, G, c;
    __host__ __device__ void init(int M, int N, int G_, int c_) { nM = M / BM; nN = N / BM; nwg = nM * nN; G = G_; c = c_; }
    __host__ __device__ bool next(int i, Unit& u) const {
        const long L = (long)i * G + c; if (L >= nwg) return false;
        int wgid = (int)L; { const int q = nwg / NXCD, r = nwg % NXCD, xcd = wgid % NXCD, off = wgid / NXCD; wgid = (xcd < r ? xcd * (q + 1) : r * (q + 1) + (xcd - r) * q) + off; }
        const int nig = WGM * nN, gid = wgid / nig, fm = gid * WGM, gsz = (nM - fm) < WGM ? (nM - fm) : WGM;
        u.pm = fm + ((wgid % nig) % gsz); u.pn = (wgid % nig) / gsz; return true;
    }
    __device__ __forceinline__ void a_ready(const Unit&) const {}
    __device__ __forceinline__ void done(const Unit&) const {}
};

__device__ __forceinline__ unsigned cvt_pk_bf16(float lo, float hi) { unsigned r; asm volatile("v_cvt_pk_bf16_f32 %0, %1, %2" : "=v"(r) : "v"(lo), "v"(hi)); return r; }
template <class Epi, class Sched, bool ALIGN_EPI = false, bool SP2 = false>
__device__ __forceinline__ void gemm_phase(PG8_LAS unsigned char* lds, const Gemm g, const Sched& S, const Epi& E, const int mk_wid) {
    const int wid = mk_wid, tid = mk_tid(mk_wid), lane = tid & 63, wr = wid >> 2, wc = wid & 3, fr = lane & 15, fq = lane >> 4;
    const int K = g.K, LD = g.ld, nt = K / BK;
    unsigned voffA[2], voffB[2];
#pragma unroll
    for (int i = 0; i < 2; ++i) { int R, C; stage_rc(tid * 16 + i * 8192, R, C); const int Rb = Epi::PERM ? ((R & ~31) + perm32(R & 31)) : R;
        voffA[i] = (unsigned)(R * LD + C) * 2u; voffB[i] = (unsigned)(Rb * LD + C) * 2u; }
    const size_t kstep = (size_t)(BK * 2);
    const size_t hstep = (size_t)HALF * LD * 2;
    const size_t tstep = 2 * hstep;
    const unsigned ldsw = (unsigned)wid * 1024u;
    const int aoff = lds_byte(wr * 64 + fr, fq * 8), boff = lds_byte(wc * 32 + fr, fq * 8);
#define PG8_SA(b, h) (((b) * 2 + (h)) * HTB)
#define PG8_SB(b, h) ((4 + (b) * 2 + (h)) * HTB)
#define PG8_STAGE(bufoff, gbase, voff) do { _Pragma("unroll") for (int _i = 0; _i < 2; ++_i) \
        __builtin_amdgcn_global_load_lds((const unsigned*)((const char*)(gbase) + (voff)[_i]), (PG8_LAS unsigned*)(lds + (bufoff) + ldsw + _i * 8192), 16, 0, 0); } while (0)
#define PG8_LDA(dst, b, h) do { _Pragma("unroll") for (int m = 0; m < 4; ++m) _Pragma("unroll") for (int k = 0; k < 2; ++k) dst[m][k] = *(const PG8_LAS bf16x8*)(lds + PG8_SA(b, h) + aoff + m * 2048 + k * 1024); } while (0)
#define PG8_LDB(dst, b, h) do { _Pragma("unroll") for (int n = 0; n < 2; ++n) _Pragma("unroll") for (int k = 0; k < 2; ++k) dst[n][k] = *(const PG8_LAS bf16x8*)(lds + PG8_SB(b, h) + boff + n * 2048 + k * 1024); } while (0)
#define PG8_MMA(ai, bj, At, Bt) do { __builtin_amdgcn_s_setprio(1); _Pragma("unroll") for (int m = 0; m < 4; ++m) _Pragma("unroll") for (int n = 0; n < 2; ++n) _Pragma("unroll") for (int k = 0; k < 2; ++k) \
        acc[ai][bj][m][n] = __builtin_amdgcn_mfma_f32_16x16x32_bf16(Bt[n][k], At[m][k], acc[ai][bj][m][n], 0, 0, 0); __builtin_amdgcn_s_setprio(0); } while (0)
#define PG8_WAIT_V(n) asm volatile("s_waitcnt vmcnt(" #n ")" ::: "memory")
#define PG8_WAIT_L(n) asm volatile("s_waitcnt lgkmcnt(" #n ")" ::: "memory")
#define PG8_BAR __builtin_amdgcn_s_barrier()
#define PG8_SCHED __builtin_amdgcn_sched_barrier(0)
    Unit cur, nxt; int ui = 0;
    if (!S.next(0, cur)) return;
    f32x4 acc[2][2][4][2];
#pragma unroll
    for (int a = 0; a < 2; ++a)
#pragma unroll
        for (int b = 0; b < 2; ++b)
#pragma unroll
            for (int m = 0; m < 4; ++m)
#pragma unroll
                for (int n = 0; n < 2; ++n) acc[a][b][m][n] = (f32x4){0.f, 0.f, 0.f, 0.f};
    bf16x8 At[4][2], B0[2][2], B1[2][2];
    const char* cA = (const char*)g.A + (size_t)cur.pm * tstep; const char* cB = (const char*)g.Bt + (size_t)cur.pn * tstep;
    S.a_ready(cur);
    if constexpr (SP2) {
        PG8_STAGE(PG8_SB(0, 0), cB, voffB); PG8_STAGE(PG8_SB(0, 1), cB + hstep, voffB); PG8_STAGE(PG8_SA(0, 0), cA, voffA); PG8_STAGE(PG8_SA(0, 1), cA + hstep, voffA);
        if (wr == 1) PG8_BAR;
        PG8_WAIT_V(2); PG8_BAR;
        PG8_STAGE(PG8_SB(1, 0), cB + kstep, voffB); PG8_STAGE(PG8_SA(1, 0), cA + kstep, voffA); PG8_STAGE(PG8_SB(1, 1), cB + hstep + kstep, voffB);
        PG8_WAIT_V(6); PG8_BAR;
    } else {
        PG8_STAGE(PG8_SB(0, 0), cB, voffB); PG8_STAGE(PG8_SA(0, 0), cA, voffA); PG8_STAGE(PG8_SB(0, 1), cB + hstep, voffB); PG8_STAGE(PG8_SA(0, 1), cA + hstep, voffA);
        if (wr == 1) PG8_BAR;
        PG8_WAIT_V(4); PG8_BAR;
        PG8_STAGE(PG8_SB(1, 0), cB + kstep, voffB); PG8_STAGE(PG8_SA(1, 0), cA + kstep, voffA); PG8_STAGE(PG8_SB(1, 1), cB + hstep + kstep, voffB);
        PG8_WAIT_V(6); PG8_BAR;
    }
    for (;;) {
        const bool has_next = S.next(ui + 1, nxt);
        const char* nA = has_next ? (const char*)g.A + (size_t)nxt.pm * tstep : cA; const char* nB = has_next ? (const char*)g.Bt + (size_t)nxt.pn * tstep : cB;
        for (int t = 0; t < nt; t += 2) {
            const bool last = (t == nt - 2);
            const char* a1 = cA + (size_t)(t + 1) * kstep;
            const char* a2 = last ? nA : cA + (size_t)(t + 2) * kstep; const char* b2 = last ? nB : cB + (size_t)(t + 2) * kstep;
            const char* a3 = a2 + kstep; const char* b3 = b2 + kstep;
            if (last && has_next) S.a_ready(nxt);
            if constexpr (SP2) {
            PG8_LDB(B0, 0, 0); PG8_LDB(B1, 0, 1); PG8_SCHED; PG8_LDA(At, 0, 0); PG8_STAGE(PG8_SA(1, 1), a1 + hstep, voffA);
            PG8_WAIT_V(8); PG8_WAIT_L(0); PG8_BAR; PG8_MMA(0, 0, At, B0); PG8_MMA(0, 1, At, B1); PG8_BAR; PG8_SCHED;
            PG8_LDA(At, 0, 1); PG8_STAGE(PG8_SB(0, 0), b2, voffB); PG8_STAGE(PG8_SB(0, 1), b2 + hstep, voffB); PG8_STAGE(PG8_SA(0, 0), a2, voffA);
            PG8_WAIT_V(8); PG8_WAIT_L(0); PG8_BAR; PG8_MMA(1, 0, At, B0); PG8_MMA(1, 1, At, B1); PG8_BAR; PG8_SCHED;
            PG8_LDB(B0, 1, 0); PG8_LDB(B1, 1, 1); PG8_SCHED; PG8_LDA(At, 1, 0); PG8_STAGE(PG8_SA(0, 1), a2 + hstep, voffA);
            PG8_WAIT_V(8); PG8_WAIT_L(0); PG8_BAR; PG8_MMA(0, 0, At, B0); PG8_MMA(0, 1, At, B1); PG8_BAR; PG8_SCHED;
            PG8_LDA(At, 1, 1); PG8_STAGE(PG8_SB(1, 0), b3, voffB); PG8_STAGE(PG8_SB(1, 1), b3 + hstep, voffB); PG8_STAGE(PG8_SA(1, 0), a3, voffA);
            PG8_WAIT_V(8); PG8_WAIT_L(0); PG8_BAR; PG8_MMA(1, 0, At, B0); PG8_MMA(1, 1, At, B1); PG8_BAR; PG8_SCHED;
            } else {
            PG8_LDB(B0, 0, 0); PG8_SCHED; PG8_LDA(At, 0, 0); PG8_STAGE(PG8_SA(1, 1), a1 + hstep, voffA);
            PG8_WAIT_L(8); PG8_BAR; PG8_WAIT_L(0); PG8_MMA(0, 0, At, B0); PG8_BAR; PG8_SCHED;
            PG8_LDB(B1, 0, 1); PG8_STAGE(PG8_SB(0, 0), b2, voffB);
            PG8_BAR; PG8_WAIT_L(0); PG8_MMA(0, 1, At, B1); PG8_BAR;
            PG8_LDA(At, 0, 1); PG8_STAGE(PG8_SA(0, 0), a2, voffA);
            PG8_BAR; PG8_WAIT_L(0); PG8_MMA(1, 0, At, B0); PG8_BAR; PG8_SCHED;
            PG8_STAGE(PG8_SB(0, 1), b2 + hstep, voffB);
            PG8_WAIT_V(6); PG8_BAR; PG8_MMA(1, 1, At, B1); PG8_BAR;
            PG8_LDB(B0, 1, 0); PG8_SCHED; PG8_LDA(At, 1, 0); PG8_STAGE(PG8_SA(0, 1), a2 + hstep, voffA);
            PG8_WAIT_L(8); PG8_BAR; PG8_WAIT_L(0); PG8_MMA(0, 0, At, B0); PG8_BAR; PG8_SCHED;
            PG8_LDB(B1, 1, 1); PG8_STAGE(PG8_SB(1, 0), b3, voffB);
            PG8_BAR; PG8_WAIT_L(0); PG8_MMA(0, 1, At, B1); PG8_BAR;
            PG8_LDA(At, 1, 1); PG8_STAGE(PG8_SA(1, 0), a3, voffA);
            PG8_BAR; PG8_WAIT_L(0); PG8_MMA(1, 0, At, B0); PG8_BAR; PG8_SCHED;
            PG8_STAGE(PG8_SB(1, 1), b3 + hstep, voffB);
            PG8_WAIT_V(6); PG8_BAR; PG8_MMA(1, 1, At, B1); PG8_BAR;
            }
        }
        if constexpr (ALIGN_EPI) { if (wr == 0) PG8_BAR; }
        if constexpr (!Epi::AFTER_DRAIN) { E(acc, cur, wr, wc, fr, fq); S.done(cur); }
        if (!has_next) break;
#pragma unroll
        for (int a = 0; a < 2; ++a)
#pragma unroll
            for (int b = 0; b < 2; ++b)
#pragma unroll
                for (int m = 0; m < 4; ++m)
#pragma unroll
                    for (int n = 0; n < 2; ++n) acc[a][b][m][n] = (f32x4){0.f, 0.f, 0.f, 0.f};
        cur = nxt; cA = nA; cB = nB; ++ui;
        if constexpr (ALIGN_EPI) { if (wr == 1) PG8_BAR; }
    }
    PG8_WAIT_V(0);
    if constexpr (!ALIGN_EPI) { if (wr == 0) PG8_BAR; }
    PG8_BAR;
    if constexpr (Epi::AFTER_DRAIN) { E.fused(acc, cur, wr, wc, fr, fq, lds, wid, lane); S.done(cur); }
#undef PG8_SA
#undef PG8_SB
#undef PG8_STAGE
#undef PG8_LDA
#undef PG8_LDB
#undef PG8_MMA
#undef PG8_WAIT_V
#undef PG8_WAIT_L
#undef PG8_BAR
#undef PG8_SCHED
}
}
namespace attn_body {
using bf16=__hip_bfloat16;
using bf16x8=__attribute__((ext_vector_type(8)))short;
using s16x4=__attribute__((ext_vector_type(4)))short;
using f32x16=__attribute__((ext_vector_type(16)))float;
using u32x4=__attribute__((ext_vector_type(4)))unsigned;
constexpr int NHEAD=8,D=64,DM=NHEAD*D;
constexpr int NW=8,QBLK=32,QB=QBLK*NW,KVBLK=64;
constexpr int ATTN_PITCH=DM, ATTN_UNIT_ROWS=QB;
__device__ __forceinline__ int crow(int r,int hi){return (r&3)+8*(r>>2)+4*hi;}
#define SBAR() __builtin_amdgcn_sched_barrier(0)
__device__ __forceinline__ void cmask(f32x16&p0,f32x16&p1,int jb,int qrel,int hi){
  const float NEG=-INFINITY; int kb=64*jb+4*hi;
  #pragma unroll
  for(int r=0;r<16;++r){int kv=kb+(r&3)+8*(r>>2); if(kv>qrel)p0[r]=NEG; if(kv+32>qrel)p1[r]=NEG;}
}

constexpr int NSLOT=3, SLOTB=8192;
constexpr int LDS_K=0, LDS_V=NSLOT*SLOTB, LDS_WS=2*NSLOT*SLOTB, LDS_OST=LDS_WS+NW*64*4, LDS_BYTES=LDS_OST+NW*4096;
constexpr float C2=0.125f*1.4426950408889634f;
__device__ __forceinline__ void glds16(const void*gsrc,unsigned lds_dst){unsigned keep;
  asm volatile("s_mov_b32 %0, m0\n\ts_mov_b32 m0, %2\n\ts_nop 0\n\tglobal_load_lds_dwordx4 %1, off\n\ts_mov_b32 m0, %0":"=&s"(keep):"v"(gsrc),"s"(lds_dst):"memory");}
__device__ __forceinline__ void glds16s(const void*sbase,unsigned voff,unsigned lds_dst){unsigned keep;
  asm volatile("s_mov_b32 %0, m0\n\ts_mov_b32 m0, %3\n\ts_nop 0\n\tglobal_load_lds_dwordx4 %1, %2\n\ts_mov_b32 m0, %0":"=&s"(keep):"v"(voff),"s"(sbase),"s"(lds_dst):"memory");}
__device__ __forceinline__ float max3f(float a,float b,float c){float r;asm("v_max3_f32 %0, %1, %2, %3":"=v"(r):"v"(a),"v"(b),"v"(c));return r;}
__device__ __forceinline__ float max2f(float a,float b){float r;asm("v_max_f32_e32 %0, %1, %2":"=v"(r):"v"(a),"v"(b));return r;}
__device__ __forceinline__ float fadd_s(float a,float b){float r;asm("v_add_f32_e32 %0, %1, %2":"=v"(r):"v"(a),"v"(b));return r;}
__device__ __forceinline__ float fsub_s(float a,float b){float r;asm("v_sub_f32_e32 %0, %1, %2":"=v"(r):"v"(a),"v"(b));return r;}
typedef float f32x2_t __attribute__((ext_vector_type(2))); typedef __bf16 bf16x2_t __attribute__((ext_vector_type(2)));
__device__ __forceinline__ unsigned cvtpk_s(float lo,float hi){f32x2_t v={lo,hi};bf16x2_t b=__builtin_convertvector(v,bf16x2_t);return __builtin_bit_cast(unsigned,b);}
#define WAIT_BAR(N) asm volatile("s_waitcnt vmcnt(" #N ") lgkmcnt(0)\n\ts_barrier":::"memory")

__device__ __forceinline__ void qkt(f32x16&p0,f32x16&p1,const char*Kslot,const bf16x8*qr,const f32x16&i0,const f32x16&i1,int r32,int hi){
  const char*kb=Kslot+hi*1024+r32*16;
  #pragma unroll
  for(int d0=0;d0<4;++d0){
    const bf16x8 b0=*reinterpret_cast<const bf16x8*>(kb+d0*2048);
    const bf16x8 b1=*reinterpret_cast<const bf16x8*>(kb+d0*2048+512);
    if(d0==0){p0=__builtin_amdgcn_mfma_f32_32x32x16_bf16(b0,qr[0],i0,0,0,0);p1=__builtin_amdgcn_mfma_f32_32x32x16_bf16(b1,qr[0],i1,0,0,0);}
    else{p0=__builtin_amdgcn_mfma_f32_32x32x16_bf16(b0,qr[d0],p0,0,0,0);p1=__builtin_amdgcn_mfma_f32_32x32x16_bf16(b1,qr[d0],p1,0,0,0);}}
}
typedef __attribute__((address_space(3))) const char* lds_cptr;
typedef short v4i16_t __attribute__((ext_vector_type(4)));
__device__ __forceinline__ void kload8(bf16x8*kf,lds_cptr kp){
  kf[0]=*(const __attribute__((address_space(3))) bf16x8*)(kp);      kf[1]=*(const __attribute__((address_space(3))) bf16x8*)(kp+512);
  kf[2]=*(const __attribute__((address_space(3))) bf16x8*)(kp+2048); kf[3]=*(const __attribute__((address_space(3))) bf16x8*)(kp+2560);
  kf[4]=*(const __attribute__((address_space(3))) bf16x8*)(kp+4096); kf[5]=*(const __attribute__((address_space(3))) bf16x8*)(kp+4608);
  kf[6]=*(const __attribute__((address_space(3))) bf16x8*)(kp+6144); kf[7]=*(const __attribute__((address_space(3))) bf16x8*)(kp+6656);
}
__device__ __forceinline__ void kload2(bf16x8*kf,lds_cptr kp,int j){ kf[2*j]=*(const __attribute__((address_space(3))) bf16x8*)(kp+j*2048); kf[2*j+1]=*(const __attribute__((address_space(3))) bf16x8*)(kp+j*2048+512); }
__device__ __forceinline__ s16x4 vtr(lds_cptr p){ return __builtin_bit_cast(s16x4,__builtin_amdgcn_ds_read_tr16_b64_v4i16((__attribute__((address_space(3))) v4i16_t*)p)); }
__device__ __forceinline__ float rowmax(const f32x16&p0,const f32x16&p1){
  float a=max3f(p0[0],p0[1],p1[0]),b=max3f(p0[2],p0[3],p1[1]);a=max3f(a,p1[2],p1[3]);
  #pragma unroll
  for(int r=4;r<16;r+=4){a=max3f(a,p0[r],p0[r+1]);b=max3f(b,p0[r+2],p0[r+3]);a=max3f(a,p1[r],p1[r+1]);b=max3f(b,p1[r+2],p1[r+3]);}
  const float m=max2f(a,b);
  auto rr=__builtin_amdgcn_permlane32_swap(__float_as_uint(m),__float_as_uint(m),false,false);
  return max2f(__uint_as_float(rr[0]),__uint_as_float(rr[1]));
}
__device__ __forceinline__ void pv(f32x16*o,int vb,bf16x8 pa0,bf16x8 pa1,bf16x8 pa2,bf16x8 pa3){
  #pragma unroll
  for(int d0=0;d0<2;++d0){s16x4 lo[4],hi[4];
    #pragma unroll
    for(int ks=0;ks<4;++ks){
      asm volatile("ds_read_b64_tr_b16 %0,%1 offset:%c2":"=&v"(lo[ks]):"v"(vb),"i"(d0*4096+ks*1024):"memory");
      asm volatile("ds_read_b64_tr_b16 %0,%1 offset:%c2":"=&v"(hi[ks]):"v"(vb),"i"(d0*4096+ks*1024+512):"memory");}
    asm volatile("s_waitcnt lgkmcnt(0)":::"memory");SBAR();
    #define PK(k) (bf16x8){lo[k][0],lo[k][1],lo[k][2],lo[k][3],hi[k][0],hi[k][1],hi[k][2],hi[k][3]}
    o[d0]=__builtin_amdgcn_mfma_f32_32x32x16_bf16(pa0,PK(0),o[d0],0,0,0);
    o[d0]=__builtin_amdgcn_mfma_f32_32x32x16_bf16(pa1,PK(1),o[d0],0,0,0);
    o[d0]=__builtin_amdgcn_mfma_f32_32x32x16_bf16(pa2,PK(2),o[d0],0,0,0);
    o[d0]=__builtin_amdgcn_mfma_f32_32x32x16_bf16(pa3,PK(3),o[d0],0,0,0);
    #undef PK
  }
}

#ifndef ATTN_STORE16
#define ATTN_STORE16(p,v) (*(u32x4*)(p)=(v))
#endif
template<int THRL> __device__ __forceinline__ void attn_unit(int q0,int nvalid,const bf16*Qu,const bf16*__restrict__ Kh,const bf16*__restrict__ Vh,bf16*Ou,const float*__restrict__ G,char*shm,const int mk_wid){
  const int wid=mk_wid,tid=mk_tid(mk_wid),lane=tid&63,r32=lane&31,hi=lane>>5;
  const bf16*Qw=Qu+(long)(wid*QBLK)*DM;
  const unsigned lds0=(unsigned)(uintptr_t)shm;
  float*wsf=(float*)(shm+LDS_WS)+wid*64;
  const unsigned kvoff=(unsigned)((lane*DM+wid*8)*2);
  const unsigned vvoff=(unsigned)(((16*(wid&3)+(lane>>2))*DM+(wid>>2)*32+(lane&3)*8)*2);
  const unsigned kdst=lds0+LDS_K+wid*1024, vdst=lds0+LDS_V+wid*1024;
  #define DMA_K(t,slot) glds16s(Kh+(long)(t)*KVBLK*DM,kvoff,(unsigned)__builtin_amdgcn_readfirstlane(kdst+(slot)))
  #define DMA_V(t,slot) glds16s(Vh+(long)(t)*KVBLK*DM,vvoff,(unsigned)__builtin_amdgcn_readfirstlane(vdst+(slot)))
  const int vb0=(int)(lds0+LDS_V)+((lane>>4)&1)*32+(lane&3)*8+(4*hi+((lane&15)>>2))*64;
  const char*Kbase=shm+LDS_K; bf16x8 kf[8];
  const lds_cptr shm3=(lds_cptr)shm; const lds_cptr kp0=shm3+LDS_K+hi*1024+r32*16; const lds_cptr vp0=shm3+LDS_V+((lane>>4)&1)*32+(lane&3)*8+(4*hi+((lane&15)>>2))*64;
  { float*fbw=(float*)(shm+LDS_OST); const float gref=G[q0]; for(int j=tid;j<q0+QB;j+=512) fbw[j]=(gref-G[j])*1.4426950408889634f; }
  const __attribute__((address_space(3))) float* fbl=(const __attribute__((address_space(3))) float*)(shm3+LDS_OST)+r32;
  #define BIASMF(t,w,bq) __builtin_amdgcn_mfma_f32_32x32x2f32((hi?1.0f:fbl[64*(t)+32*(w)]),(bq),negm,0,0,0)
  const int NT=(q0+QB)/KVBLK;
  DMA_K(0,0);DMA_V(0,0);DMA_K(1,SLOTB);
  bf16x8 qr[4];
  #pragma unroll
  for(int d0=0;d0<4;++d0)qr[d0]=*reinterpret_cast<const bf16x8*>(&Qw[(long)r32*DM+d0*16+hi*8]);
  float mhat=0.f,l_reg=0.f;f32x16 o[2];o[0]=f32x16{};o[1]=f32x16{};const f32x16 negm=f32x16{};
  const int qrel=wid*QBLK+r32;
  #define CMASK(P0,P1,t) do{int jb_=(t)-(NT-4); if(jb_>=0)cmask(P0,P1,jb_,qrel,hi);}while(0)
  bool resc=false;
  #define START(P0,P1) do{ const float rm=rowmax(P0,P1); resc=false; \
    { const float dl=rm; mhat=fadd_s(mhat,dl); \
      _Pragma("unroll") for(int r=0;r<16;++r){P0[r]=fsub_s(P0[r],dl);P1[r]=fsub_s(P1[r],dl);} \
      } \
    _Pragma("unroll") for(int r=0;r<16;++r)P0[r]=__builtin_amdgcn_exp2f(P0[r]); }while(0)
  #define RESC() do{ if(resc){ asm volatile("s_waitcnt lgkmcnt(0)":::"memory"); \
      _Pragma("unroll") for(int d_=0;d_<2;++d_) _Pragma("unroll") for(int r=0;r<16;++r)o[d_][r]*=wsf[crow(r,hi)]; } }while(0)
  f32x16 pA0,pA1,pB0,pB1;
  int sl_prev=0,sl_cur=0,sl_next=SLOTB;
  #define ROT() do{sl_prev=sl_cur;sl_cur=sl_next;sl_next=(sl_next==(NSLOT-1)*SLOTB)?0:sl_next+SLOTB;}while(0)
  DMA_K(2,2*SLOTB);
  WAIT_BAR(3);
  { const float bq0_=hi?0.f:1.f; qkt(pA0,pA1,Kbase,qr,BIASMF(0,0,bq0_),BIASMF(0,1,bq0_),r32,hi); }asm volatile("s_nop 15\n\ts_nop 7":"+v"(pA0),"+v"(pA1));CMASK(pA0,pA1,0);
  START(pA0,pA1);
  _Pragma("unroll") for(int r=0;r<16;++r)pA1[r]=__builtin_amdgcn_exp2f(pA1[r]);
  WAIT_BAR(0);
  DMA_K(3,0);DMA_V(1,SLOTB);
  ROT();
  kload8(kf,kp0+sl_cur);
  WAIT_BAR(2);
  s16x4 vlo[8],vhi[8]; u32x4 pw0,pw1,pw2,pw3;
  #define PKW(P,B) cvtpk_s(P[B],P[B+1])
  #define PAF(k) __builtin_bit_cast(bf16x8,pw##k)
  #define VFR(i) (bf16x8){vlo[i][0],vlo[i][1],vlo[i][2],vlo[i][3],vhi[i][0],vhi[i][1],vhi[i][2],vhi[i][3]}
  #define PIN(x) asm volatile("":"+v"(x))
  #define MX3(a,b,c) __builtin_fmaxf(__builtin_fmaxf((a),(b)),(c))
  #define GAPA(MF,A0,A1,A2,A3,W0,W1,PW) do{ MF; sacc+=A0; sacc+=A1; sacc+=A2; sacc+=A3; PIN(sacc); W0; W1; PIN(PW); SBAR(); }while(0)
  #define EX(v) __builtin_amdgcn_exp2f(v)
  #define GAPB(MF,X,B) do{ MF; X[B]=EX(X[B]); X[B+1]=EX(X[B+1]); X[B+2]=EX(X[B+2]); X[B+3]=EX(X[B+3]); PIN(X); SBAR(); }while(0)
  #define VRD(i) do{ vlo[i]=vtr(vp_+(((i)>>2)*4096+((i)&3)*1024)); vhi[i]=vtr(vp_+(((i)>>2)*4096+((i)&3)*1024+512)); }while(0)
  #define KRD(G,j) do{ if(G){ kload2(kf,kp0+sl_next,j); SBAR(); } }while(0)
  #define STEP(C0,C1,P0,P1,t,GK,GV,GL) do{ SBAR(); \
    const lds_cptr vp_=vp0+sl_prev; \
    const float bq_=hi?-mhat:1.0f; float ba0_=fbl[64*(t)], ba1_=fbl[64*(t)+32]; asm volatile("":"+v"(ba0_),"+v"(ba1_)); SBAR(); VRD(0); SBAR(); float sacc=(P0[0]+P0[1]); \
    GAPA(C0=__builtin_amdgcn_mfma_f32_32x32x16_bf16(kf[0],qr[0],__builtin_amdgcn_mfma_f32_32x32x2f32((hi?1.0f:ba0_),bq_,negm,0,0,0),0,0,0), P0[2],P0[3],P0[4],P0[5],     pw0[0]=PKW(P0,0), pw0[1]=PKW(P0,2), pw0); \
    VRD(4); SBAR(); GAPA(C1=__builtin_amdgcn_mfma_f32_32x32x16_bf16(kf[1],qr[0],__builtin_amdgcn_mfma_f32_32x32x2f32((hi?1.0f:ba1_),bq_,negm,0,0,0),0,0,0), P0[6],P0[7],P0[8],P0[9],     pw0[2]=PKW(P0,4), pw0[3]=PKW(P0,6), pw0); \
    VRD(1); SBAR(); GAPA(C0=__builtin_amdgcn_mfma_f32_32x32x16_bf16(kf[2],qr[1],C0,0,0,0),   P0[10],P0[11],P0[12],P0[13], pw1[0]=PKW(P0,8), pw1[1]=PKW(P0,10), pw1); \
    VRD(5); SBAR(); GAPA(C1=__builtin_amdgcn_mfma_f32_32x32x16_bf16(kf[3],qr[1],C1,0,0,0),   P0[14],P0[15],P1[0],P1[1],   pw1[2]=PKW(P0,12),pw1[3]=PKW(P0,14), pw1); \
    VRD(2); SBAR(); GAPA(C0=__builtin_amdgcn_mfma_f32_32x32x16_bf16(kf[4],qr[2],C0,0,0,0),   P1[2],P1[3],P1[4],P1[5],     pw2[0]=PKW(P1,0), pw2[1]=PKW(P1,2), pw2); \
    VRD(6); SBAR(); GAPA(C1=__builtin_amdgcn_mfma_f32_32x32x16_bf16(kf[5],qr[2],C1,0,0,0),   P1[6],P1[7],P1[8],P1[9],     pw2[2]=PKW(P1,4), pw2[3]=PKW(P1,6), pw2); \
    VRD(3); SBAR(); GAPA(C0=__builtin_amdgcn_mfma_f32_32x32x16_bf16(kf[6],qr[3],C0,0,0,0),   P1[10],P1[11],P1[12],P1[13], pw3[0]=PKW(P1,8), pw3[1]=PKW(P1,10), pw3); \
    VRD(7); SBAR(); GAPA(C1=__builtin_amdgcn_mfma_f32_32x32x16_bf16(kf[7],qr[3],C1,0,0,0),   P1[14],P1[15],0.f,0.f,       pw3[2]=PKW(P1,12),pw3[3]=PKW(P1,14), pw3); \
    l_reg+=sacc; \
    if(GK){DMA_K((t)+3,sl_cur);} if(GV){DMA_V((t)+1,sl_next);} \
    CMASK(C0,C1,t); \
    { float a=MX3(C0[0],C0[1],C1[0]),b=MX3(C0[2],C0[3],C1[1]); a=MX3(a,C1[2],C1[3]); \
      _Pragma("unroll") for(int r=4;r<16;r+=4){a=MX3(a,C0[r],C0[r+1]);b=MX3(b,C0[r+2],C0[r+3]);a=MX3(a,C1[r],C1[r+1]);b=MX3(b,C1[r+2],C1[r+3]);} \
      float rm=__builtin_fmaxf(a,b); { auto rr=__builtin_amdgcn_permlane32_swap(__float_as_uint(rm),__float_as_uint(rm),false,false); rm=__builtin_fmaxf(__uint_as_float(rr[0]),__uint_as_float(rr[1])); } \
      resc=false; \
      if(__builtin_expect(__any(rm>(float)THRL),0)){ const float dl=__builtin_fmaxf(rm,0.f); mhat+=dl; \
        _Pragma("unroll") for(int r=0;r<16;++r){C0[r]-=dl;C1[r]-=dl;} \
        const float f=__builtin_amdgcn_exp2f(-dl); l_reg*=f; if(hi==0)wsf[r32]=f; resc=true; } } \
    SBAR(); \
    GAPB(o[0]=__builtin_amdgcn_mfma_f32_32x32x16_bf16(PAF(0),VFR(0),o[0],0,0,0), C0,0); \
    GAPB(o[1]=__builtin_amdgcn_mfma_f32_32x32x16_bf16(PAF(0),VFR(4),o[1],0,0,0), C0,4); \
    KRD(GL,0); GAPB(o[0]=__builtin_amdgcn_mfma_f32_32x32x16_bf16(PAF(1),VFR(1),o[0],0,0,0), C0,8); \
    KRD(GL,1); GAPB(o[1]=__builtin_amdgcn_mfma_f32_32x32x16_bf16(PAF(1),VFR(5),o[1],0,0,0), C0,12); \
    KRD(GL,2); GAPB(o[0]=__builtin_amdgcn_mfma_f32_32x32x16_bf16(PAF(2),VFR(2),o[0],0,0,0), C1,0); \
    KRD(GL,3); GAPB(o[1]=__builtin_amdgcn_mfma_f32_32x32x16_bf16(PAF(2),VFR(6),o[1],0,0,0), C1,4); \
    GAPB(o[0]=__builtin_amdgcn_mfma_f32_32x32x16_bf16(PAF(3),VFR(3),o[0],0,0,0), C1,8); \
    GAPB(o[1]=__builtin_amdgcn_mfma_f32_32x32x16_bf16(PAF(3),VFR(7),o[1],0,0,0), C1,12); \
    }while(0)
  int t=1;
  #undef CMASK
  #define CMASK(P0,P1,t) do{}while(0)
  for(;t+5<NT;t+=2){
    STEP(pB0,pB1,pA0,pA1,t,true,true,true);     WAIT_BAR(2); RESC(); ROT();
    STEP(pA0,pA1,pB0,pB1,t+1,true,true,true);   WAIT_BAR(2); RESC(); ROT();
  }
  #undef CMASK
  #define CMASK(P0,P1,t) do{int jb_=(t)-(NT-4); if(jb_>=0)cmask(P0,P1,jb_,qrel,hi);}while(0)
  #define ENDW(tt) do{ if((tt)+3<NT){WAIT_BAR(2);} else if((tt)+2<NT){WAIT_BAR(1);} else {WAIT_BAR(0);} }while(0)
  for(;t+1<NT;t+=2){
    STEP(pB0,pB1,pA0,pA1,t,(t+3<NT),(t+1<NT),(t+1<NT));       ENDW(t);   RESC(); ROT();
    STEP(pA0,pA1,pB0,pB1,t+1,(t+4<NT),(t+2<NT),(t+2<NT));     ENDW(t+1); RESC(); ROT();
  }
  STEP(pB0,pB1,pA0,pA1,NT-1,false,false,false); RESC();
  { float sacc=pB0[0]+pB0[1]; _Pragma("unroll") for(int r=2;r<16;++r)sacc+=pB0[r]; _Pragma("unroll") for(int r=0;r<16;++r)sacc+=pB1[r]; l_reg+=sacc;
    pw0=(u32x4){PKW(pB0,0),PKW(pB0,2),PKW(pB0,4),PKW(pB0,6)};pw1=(u32x4){PKW(pB0,8),PKW(pB0,10),PKW(pB0,12),PKW(pB0,14)};pw2=(u32x4){PKW(pB1,0),PKW(pB1,2),PKW(pB1,4),PKW(pB1,6)};pw3=(u32x4){PKW(pB1,8),PKW(pB1,10),PKW(pB1,12),PKW(pB1,14)};
    SBAR(); pv(o,vb0+sl_cur,PAF(0),PAF(1),PAF(2),PAF(3)); }
  #undef PKW
  #undef PAF
  #undef VFR
  #undef PIN
  #undef MX3
  #undef GAPA
  #undef GAPB
  #undef EX
  #undef VRD
  #undef KRD
  #undef STEP
  #undef ENDW
  {auto rr=__builtin_amdgcn_permlane32_swap(__float_as_uint(l_reg),__float_as_uint(l_reg),false,false);l_reg=__uint_as_float(rr[0])+__uint_as_float(rr[1]);}
  if(hi==0)wsf[32+r32]=l_reg;asm volatile("s_waitcnt lgkmcnt(0)":::"memory");
  float rli[16];
  #pragma unroll
  for(int r=0;r<16;++r)rli[r]=__builtin_amdgcn_rcpf(wsf[32+crow(r,hi)]);
  bf16*Ow=Ou+(long)(wid*QBLK)*DM;
  asm volatile("s_waitcnt lgkmcnt(0)\n\ts_barrier":::"memory");
  { bf16*stg=(bf16*)(shm+LDS_OST)+wid*2048;
    #pragma unroll
    for(int r=0;r<16;++r){const int orow=crow(r,hi);
      #pragma unroll
      for(int d0=0;d0<2;++d0)stg[orow*64+d0*32+r32]=__float2bfloat16(o[d0][r]*rli[r]);}
    asm volatile("s_waitcnt lgkmcnt(0)":::"memory");
    #pragma unroll
    for(int i=0;i<4;++i){const int row=i*8+(lane>>3),ch=lane&7; const u32x4 v=*(const u32x4*)(stg+row*64+ch*8); if(wid*QBLK+row<nvalid)ATTN_STORE16(Ow+(long)row*DM+ch*8,v);} }
  asm volatile("s_waitcnt lgkmcnt(0)\n\ts_barrier":::"memory");
  #undef BIASMF
  #undef DMA_K
  #undef DMA_V
  #undef CMASK
  #undef START
  #undef RESC
  #undef ROT
}
constexpr int ATTN_LDS_BYTES=LDS_BYTES;
#undef SBAR
#undef WAIT_BAR
}

namespace mk {
#define LAS __attribute__((address_space(3)))
typedef unsigned short bf16_t;
typedef short bf16x8 __attribute__((ext_vector_type(8)));
typedef float f32x4 __attribute__((ext_vector_type(4)));
typedef unsigned u32x4 __attribute__((ext_vector_type(4)));
typedef unsigned u32x2 __attribute__((ext_vector_type(2)));

constexpr int DMODEL = 1024, NPROMPT = 32768, NSAMP = 256, MROWS = 33024, SEQ = 8192, NZ = 5888, DFF = 4096;
constexpr int SKV = 2304, PAST = 2048, NCHUNK = 4224;
constexpr float EPS = 1e-6f;
constexpr size_t MiB = (size_t)1 << 20;
constexpr size_t WS_WIN = 0, WS_WPA = 12 * MiB, WS_WPB = 13 * MiB, WS_WOUT = 14 * MiB, WS_WUP = 16 * MiB, WS_WDN = 24 * MiB;
constexpr size_t WS_CTL = 32 * MiB;
constexpr size_t CTL_BYTES = 4096;
constexpr size_t WS_RS1 = 106 * MiB, WS_RS2 = 170 * MiB;
constexpr size_t WS_BAR = 32 * MiB + 512 * 1024;
constexpr size_t WS_GB = 33 * MiB;
constexpr size_t WS_GCP = 36 * MiB, WS_GCS = 37 * MiB;
constexpr size_t WS_QP = 40 * MiB;
constexpr size_t WS_KP = 73 * MiB, WS_VP = 105 * MiB;
constexpr size_t WS_QS = 137 * MiB;
constexpr size_t WS_KS = 141 * MiB, WS_VS = 177 * MiB;
constexpr size_t WS_ZC = 213 * MiB;
constexpr size_t WS_GG = 310 * MiB;
constexpr size_t WS_QG = 343 * MiB, WS_KG = 376 * MiB, WS_KTG = 409 * MiB, WS_WG = 442 * MiB, WS_UTG = 475 * MiB, WS_GCG = 508 * MiB;
constexpr size_t WS_XN = 447 * MiB + MiB / 2;
constexpr size_t WS_VNT = 213 * MiB, WS_ST = 246 * MiB;
constexpr size_t WS_OG = 73 * MiB;
constexpr size_t WS_TMP = 141 * MiB, WS_MB = 213 * MiB, WS_MIX = 343 * MiB, WS_XN2 = 141 * MiB, WS_H = 213 * MiB, WS_DOWN = 40 * MiB;
constexpr size_t WS_DOWNP = 206 * MiB;
constexpr size_t WS_END = 512 * MiB;
constexpr size_t O_Y = 0, O_FKP = 33816576, O_FVP = 50593792, O_LFP = 67371008, O_SGP = 67633152, O_CVP = 67764224,
                 O_FKS = 67782656, O_FVS = 67913728, O_LFS = 68044800, O_SGS = 68046848, O_CVS = 68571136, O_END = 68644864;
constexpr int LDS_BYTES = 147456;
constexpr float C2 = 0.125f * 1.4426950408889634f;

struct Params { const float* in[22]; float* out; unsigned char* ws; int ph_lo, ph_hi; };
typedef const __attribute__((address_space(4))) Params* KP;

typedef float f32x2_t __attribute__((ext_vector_type(2))); typedef __bf16 bf16x2_t __attribute__((ext_vector_type(2)));
__device__ __forceinline__ unsigned cvtpk(float lo, float hi) { const f32x2_t v = {lo, hi}; const bf16x2_t b = __builtin_convertvector(v, bf16x2_t); return __builtin_bit_cast(unsigned, b); }
__device__ __forceinline__ float bflo(unsigned u) { return __uint_as_float(u << 16); }
__device__ __forceinline__ float bfhi(unsigned u) { return __uint_as_float(u & 0xffff0000u); }
__device__ __forceinline__ float bf2f(bf16_t h) { return __uint_as_float((unsigned)h << 16); }
__device__ __forceinline__ float sigmoidf_(float x) { return 1.0f / (1.0f + __expf(-x)); }
__device__ __forceinline__ float softplusf_(float x) { return fmaxf(x, 0.f) + log1pf(__expf(-fabsf(x))); }
__device__ __forceinline__ float wave_sum(float v) {
#pragma unroll
    for (int o = 32; o > 0; o >>= 1) v += __shfl_xor(v, o);
    return v;
}
__device__ __forceinline__ u32x4 pack8(const f32x4& a, const f32x4& b) { u32x4 w; w.x = cvtpk(a[0], a[1]); w.y = cvtpk(a[2], a[3]); w.z = cvtpk(b[0], b[1]); w.w = cvtpk(b[2], b[3]); return w; }
__device__ __forceinline__ bf16x8 ld2x8(const bf16_t* p0, const bf16_t* p1) { const u32x2 a = *(const u32x2*)p0, b = *(const u32x2*)p1; const u32x4 v = {a.x, a.y, b.x, b.y}; return __builtin_bit_cast(bf16x8, v); }
#define MFMA16(a, b, c) __builtin_amdgcn_mfma_f32_16x16x32_bf16((a), (b), (c), 0, 0, 0)

using pg8::Unit;
struct EpiIn {
    static constexpr bool PERM = true, AFTER_DRAIN = false;
    float* out; unsigned char* ws; const float* fbias; const float* alog; const float* dtb;
    __device__ __forceinline__ void emit(int pn, int row, int cl, f32x4 v0, f32x4 v1) const {
        const bool samp = row >= NPROMPT; const int sr = row - NPROMPT;
        const int c = pn * 256 + cl;
        if (pn < 2) {
            bf16_t* dst = samp ? (bf16_t*)(ws + WS_QS) + ((size_t)((sr >> 4) * 256 + (sr & 15)) * 512 + c) : (bf16_t*)(ws + WS_QP) + ((size_t)row * 512 + c);
            *(u32x4*)dst = pack8(v0 * C2, v1 * C2);
        } else if (pn < 6) {
            const bool isv = pn >= 4; const int cc = c - (isv ? 1024 : 512);
            float* fo = out + (samp ? (isv ? O_FVS : O_FKS) + (size_t)sr * 512 : (isv ? O_FVP : O_FKP) + (size_t)row * 512) + cc;
            __builtin_nontemporal_store(v0, (f32x4*)fo); __builtin_nontemporal_store(v1, (f32x4*)(fo + 4));
            bf16_t* dst = samp ? (bf16_t*)(ws + (isv ? WS_VS : WS_KS)) + ((size_t)((sr >> 4) * SKV + PAST + (sr & 15)) * 512 + cc)
                               : (bf16_t*)(ws + (isv ? WS_VP : WS_KP)) + ((size_t)row * 512 + cc);
            *(u32x4*)dst = pack8(v0, v1);
        } else if (pn < 12) {
            const int cc = c - 1536;
            *(u32x4*)((bf16_t*)(ws + WS_ZC) + ((size_t)row * 1536 + cc)) = pack8(v0, v1);
            if (samp) { const int t = sr & 15; if (t >= 13) { float* fo = out + O_CVS + (size_t)((sr >> 4) * 3 + t - 13) * 1536 + cc; *(f32x4*)fo = v0; *(f32x4*)(fo + 4) = v1; } }
            else { const int t = row & 8191; if (t >= 8189) { float* fo = out + O_CVP + (size_t)((row >> 13) * 3 + t - 8189) * 1536 + cc; *(f32x4*)fo = v0; *(f32x4*)(fo + 4) = v1; } }
        } else if (pn < 14) {
            const int cc = c - 3072;
            *(u32x4*)((bf16_t*)(ws + WS_GG) + ((size_t)row * 512 + cc)) = pack8(v0, v1);
        } else if (pn < 22) {
            const int cc = c - 3584; f32x4 s0, s1;
#pragma unroll
            for (int e = 0; e < 4; ++e) { s0[e] = sigmoidf_(v0[e]); s1[e] = sigmoidf_(v1[e]); }
            *(u32x4*)((bf16_t*)out + ((size_t)row * 2048 + cc)) = pack8(s0, s1);
        } else {
            const int cc = c - 5632;
            if (cc == 0) { f32x4 a, b;
#pragma unroll
                for (int e = 0; e < 4; ++e) { a[e] = -softplusf_(-(v0[e] + fbias[e])); b[e] = -softplusf_(-(v1[e] + fbias[4 + e])); }
                float* fo = out + (samp ? O_LFS + (size_t)sr * 8 : O_LFP + (size_t)row * 8); *(f32x4*)fo = a; *(f32x4*)(fo + 4) = b;
            } else if (cc == 8) { f32x4 a, b;
#pragma unroll
                for (int e = 0; e < 4; ++e) { a[e] = -__expf(alog[e]) * softplusf_(v0[e] + dtb[e]); b[e] = -__expf(alog[4 + e]) * softplusf_(v1[e] + dtb[4 + e]); }
                float* fo = (float*)(ws + WS_GB) + (size_t)row * 16; *(f32x4*)fo = a; *(f32x4*)(fo + 4) = b;
            } else if (cc == 16) { f32x4 a, b;
#pragma unroll
                for (int e = 0; e < 4; ++e) { a[e] = sigmoidf_(v0[e]); b[e] = sigmoidf_(v1[e]); }
                float* fo = (float*)(ws + WS_GB) + (size_t)row * 16 + 8; *(f32x4*)fo = a; *(f32x4*)(fo + 4) = b;
            }
        }
    }
#define EPI_ROWS(PNEXPR) do { _Pragma("unroll") for (int ai = 0; ai < 2; ++ai) _Pragma("unroll") for (int m = 0; m < 4; ++m) { const int row = u.pm * 256 + ai * 128 + wr * 64 + m * 16 + fr; \
            _Pragma("unroll") for (int bj = 0; bj < 2; ++bj) emit((PNEXPR), row, bj * 128 + wc * 32 + 8 * fq, acc[ai][bj][m][0], acc[ai][bj][m][1]); } } while (0)
    __device__ __forceinline__ void operator()(const f32x4 (&acc)[2][2][4][2], const Unit& u, int wr, int wc, int fr, int fq) const {
        const int pn = u.pn;
        if (pn < 2) EPI_ROWS(pn & 1);
        else if (pn < 4) EPI_ROWS(2 + (pn & 1));
        else if (pn < 6) EPI_ROWS(4 + (pn & 1));
        else if (pn < 12) EPI_ROWS(pn < 9 ? (pn < 7 ? 6 : (pn < 8 ? 7 : 8)) : (pn < 10 ? 9 : (pn < 11 ? 10 : 11)));
        else if (pn < 14) EPI_ROWS(12 + (pn & 1));
        else if (pn < 22) EPI_ROWS(pn < 18 ? (pn < 16 ? (pn < 15 ? 14 : 15) : (pn < 17 ? 16 : 17)) : (pn < 20 ? (pn < 19 ? 18 : 19) : (pn < 21 ? 20 : 21)));
        else { if (wc == 0 && fq < 3) {
#pragma unroll
            for (int ai = 0; ai < 2; ++ai)
#pragma unroll
                for (int m = 0; m < 4; ++m) { const int row = u.pm * 256 + ai * 128 + wr * 64 + m * 16 + fr; emit(22, row, 8 * fq, acc[ai][0][m][0], acc[ai][0][m][1]); } } }
    }
#undef EPI_ROWS
};
template <int MODE> struct EpiBf {
    static constexpr bool PERM = true, AFTER_DRAIN = false;
    float* out; unsigned char* ws;
    __device__ __forceinline__ void operator()(const f32x4 (&acc)[2][2][4][2], const Unit& u, int wr, int wc, int fr, int fq) const {
#pragma unroll
        for (int ai = 0; ai < 2; ++ai)
#pragma unroll
            for (int m = 0; m < 4; ++m) { const int row = u.pm * 256 + ai * 128 + wr * 64 + m * 16 + fr;
#pragma unroll
                for (int bj = 0; bj < 2; ++bj) { const int c = u.pn * 256 + bj * 128 + wc * 32 + 8 * fq; f32x4 v0 = acc[ai][bj][m][0], v1 = acc[ai][bj][m][1];
                    if (MODE == 2) {
#pragma unroll
                        for (int e = 0; e < 4; ++e) { const float a = fmaxf(v0[e], 0.f), b = fmaxf(v1[e], 0.f); v0[e] = a * a; v1[e] = b * b; }
                        __builtin_nontemporal_store(pack8(v0, v1), (u32x4*)((bf16_t*)(ws + WS_H) + ((size_t)row * DFF + c)));
                    } else {
                        const u32x4 gt = *(const u32x4*)((const bf16_t*)out + ((size_t)row * 2048 + (MODE == 1 ? 1024 : 0) + c));
                        const f32x4 g0 = {bflo(gt.x), bfhi(gt.x), bflo(gt.y), bfhi(gt.y)}, g1 = {bflo(gt.z), bfhi(gt.z), bflo(gt.w), bfhi(gt.w)};
                        v0 = v0 * g0; v1 = v1 * g1;
                        bf16_t* tp = (bf16_t*)(ws + WS_TMP) + ((size_t)row * 1024 + c);
                        if (MODE == 0) *(u32x4*)tp = pack8(v0, v1);
                        else { const u32x4 t = *(const u32x4*)tp; const f32x4 t0 = {bflo(t.x), bfhi(t.x), bflo(t.y), bfhi(t.y)}, t1 = {bflo(t.z), bfhi(t.z), bflo(t.w), bfhi(t.w)};
                            *(u32x4*)((bf16_t*)(ws + WS_MB) + ((size_t)row * 1024 + c)) = pack8(v0 + t0, v1 + t1); }
                    } } }
    }
};
struct EpiF32SS {
    static constexpr bool PERM = true, AFTER_DRAIN = false;
    float* dst; float* rowss;
    __device__ __forceinline__ void operator()(const f32x4 (&acc)[2][2][4][2], const Unit& u, int wr, int wc, int fr, int fq) const {
#pragma unroll
        for (int ai = 0; ai < 2; ++ai)
#pragma unroll
            for (int m = 0; m < 4; ++m) { const int row = u.pm * 256 + ai * 128 + wr * 64 + m * 16 + fr; float s = 0.f;
#pragma unroll
                for (int bj = 0; bj < 2; ++bj) { const int c = u.pn * 256 + bj * 128 + wc * 32 + 8 * fq; const f32x4 v0 = acc[ai][bj][m][0], v1 = acc[ai][bj][m][1];
                    *(u32x4*)((bf16_t*)dst + (size_t)row * 1024 + c) = pack8(v0, v1);
#pragma unroll
                    for (int e = 0; e < 4; ++e) s += v0[e] * v0[e] + v1[e] * v1[e]; }
                s += __shfl_xor(s, 16); s += __shfl_xor(s, 32);
                if (fq == 0) rowss[(size_t)row * 16 + u.pn * 4 + wc] = s; }
    }
};

struct SplitOrder {
    int bid;
    __device__ __forceinline__ bool next(int i, Unit& u) const { if (i > 0 || bid >= 16) return false; u.pm = 128; u.pn = bid & 3; return true; }
    __device__ __forceinline__ void a_ready(const Unit&) const {}
    __device__ __forceinline__ void done(const Unit&) const {}
};
struct EpiPart {
    static constexpr bool PERM = true, AFTER_DRAIN = false;
    float* dst;
    __device__ __forceinline__ void operator()(const f32x4 (&acc)[2][2][4][2], const Unit& u, int wr, int wc, int fr, int fq) const {
#pragma unroll
        for (int ai = 0; ai < 2; ++ai)
#pragma unroll
            for (int m = 0; m < 4; ++m) { const int row = ai * 128 + wr * 64 + m * 16 + fr;
#pragma unroll
                for (int bj = 0; bj < 2; ++bj) { const int c = u.pn * 256 + bj * 128 + wc * 32 + 8 * fq; float* fo = dst + (size_t)row * 1024 + c; *(f32x4*)fo = acc[ai][bj][m][0]; *(f32x4*)(fo + 4) = acc[ai][bj][m][1]; } }
    }
};

__device__ __forceinline__ int srccol(int n) {
    if (n < 1536) return n;
    if (n < 3072) return n + 8;
    if (n < 5632) return n + 24;
    if (n < 5640) return 1536 + (n - 5632);
    if (n < 5648) return 3080 + (n - 5640);
    if (n < 5656) return 3088 + (n - 5648);
    return -1;
}
__device__ __forceinline__ void phase0(KP p, unsigned char* lds, const int mk_wid) {
    const int wid = mk_wid, tid = mk_tid(mk_wid), lane = tid & 63, nbt = gridDim.x, bidt = blockIdx.x;
    const int nbw = (nbt * 3) / 8;
    const int nb = bidt < nbw ? nbw : nbt - nbw, bid = bidt < nbw ? bidt : bidt - nbw; const bool do_w = bidt < nbw, do_x = bidt >= nbw;
    unsigned* ctl = (unsigned*)(p->ws + WS_CTL);
    for (int i = bidt * 512 + tid; i < (int)(CTL_BYTES / 4); i += nbt * 512) ctl[i] = 0u;
    float* tile = (float*)lds;
    if (do_w) {
#define TDECODE(t) do { remap = false; \
        if ((t) < 1472) { src = p->in[7]; ldsrc = 5656; K = 1024; dst = (bf16_t*)(p->ws + WS_WIN); n0 = ((t) >> 4) * 64; k0 = ((t) & 15) * 64; remap = true; } \
        else if ((t) < 1600) { const int q = (t) - 1472; src = p->in[13]; ldsrc = 1024; K = 512; dst = (bf16_t*)(p->ws + WS_WPA); n0 = (q >> 3) * 64; k0 = (q & 7) * 64; } \
        else if ((t) < 1728) { const int q = (t) - 1600; src = p->in[14]; ldsrc = 1024; K = 512; dst = (bf16_t*)(p->ws + WS_WPB); n0 = (q >> 3) * 64; k0 = (q & 7) * 64; } \
        else if ((t) < 1984) { const int q = (t) - 1728; src = p->in[15]; ldsrc = 1024; K = 1024; dst = (bf16_t*)(p->ws + WS_WOUT); n0 = (q >> 4) * 64; k0 = (q & 15) * 64; } \
        else if ((t) < 3008) { const int q = (t) - 1984; src = p->in[20]; ldsrc = 4096; K = 1024; dst = (bf16_t*)(p->ws + WS_WUP); n0 = (q >> 4) * 64; k0 = (q & 15) * 64; } \
        else { const int q = (t) - 3008; src = p->in[21]; ldsrc = 1024; K = 4096; dst = (bf16_t*)(p->ws + WS_WDN); n0 = (q >> 6) * 64; k0 = (q & 63) * 64; } } while (0)
#define TLOAD(tv) do { const int nn = tid & 63; int col = n0 + nn; if (remap) col = srccol(col); \
        _Pragma("unroll") for (int i = 0; i < 8; ++i) { const int kk = (tid >> 6) + 8 * i; tv[i] = col >= 0 ? __builtin_nontemporal_load(src + (size_t)(k0 + kk) * ldsrc + col) : 0.f; } } while (0)
        const float* src; bf16_t* dst; int ldsrc, K, n0, k0; bool remap; float tv[8];
        int t = bid;
        if (t < 4032) { TDECODE(t); TLOAD(tv); }
        for (; t < 4032; t += nb) {
            bf16_t* dcur = dst; const int Kc = K, n0c = n0, k0c = k0;
            { const int nn = tid & 63;
#pragma unroll
              for (int i = 0; i < 8; ++i) { const int kk = (tid >> 6) + 8 * i; tile[kk * 65 + nn] = tv[i]; } }
            __syncthreads();
            if (t + nb < 4032) { TDECODE(t + nb); TLOAD(tv); }
            __builtin_amdgcn_sched_barrier(0);
            { const int nn = tid >> 3, kq = tid & 7; float v[8];
#pragma unroll
              for (int jx = 0; jx < 8; ++jx) v[jx] = tile[(kq * 8 + jx) * 65 + nn];
              u32x4 w; w.x = cvtpk(v[0], v[1]); w.y = cvtpk(v[2], v[3]); w.z = cvtpk(v[4], v[5]); w.w = cvtpk(v[6], v[7]);
              *(u32x4*)(dcur + (size_t)(n0c + nn) * Kc + k0c + kq * 8) = w; }
            __syncthreads();
        }
#undef TDECODE
#undef TLOAD
    }
    if (do_x) { const float* gain = p->in[16]; bf16_t* XN = (bf16_t*)(p->ws + WS_XN);
      for (int rowa = bid * 8 + wid; rowa < MROWS; rowa += 2 * nb * 8) {
          int rows[2]; rows[0] = rowa; rows[1] = rowa + nb * 8 < MROWS ? rowa + nb * 8 : rowa;
          f32x4 v[2][4];
#pragma unroll
          for (int q = 0; q < 2; ++q) { const int row = rows[q]; const float* xr = row < NPROMPT ? p->in[0] + (size_t)row * 1024 : p->in[1] + (size_t)(row - NPROMPT) * 1024;
#pragma unroll
              for (int i = 0; i < 4; ++i) v[q][i] = __builtin_nontemporal_load((const f32x4*)(xr + lane * 4 + 256 * i)); }
          __builtin_amdgcn_sched_barrier(0);
#pragma unroll
          for (int q = 0; q < 2; ++q) { const int row = rows[q]; float ss = 0.f;
#pragma unroll
              for (int i = 0; i < 4; ++i) ss += v[q][i][0] * v[q][i][0] + v[q][i][1] * v[q][i][1] + v[q][i][2] * v[q][i][2] + v[q][i][3] * v[q][i][3];
              ss = wave_sum(ss); const float rs = rsqrtf(ss * (1.0f / 1024.0f) + EPS);
#pragma unroll
              for (int i = 0; i < 4; ++i) { const f32x4 g = *(const f32x4*)(gain + lane * 4 + 256 * i); const f32x4 y = v[q][i] * rs * g;
                  u32x2 w; w.x = cvtpk(y[0], y[1]); w.y = cvtpk(y[2], y[3]); *(u32x2*)(XN + (size_t)row * 1024 + lane * 4 + 256 * i) = w; } } } }
    if (do_x) { bf16_t* KS = (bf16_t*)(p->ws + WS_KS); bf16_t* VS = (bf16_t*)(p->ws + WS_VS);
      for (int e0 = bid * 512 + tid; e0 < 4194304; e0 += 4 * nb * 512) { f32x4 kv[4], vv[4];
#pragma unroll
          for (int q = 0; q < 4; ++q) { const int e = e0 + q * nb * 512; if (e < 4194304) { kv[q] = __builtin_nontemporal_load((const f32x4*)p->in[2] + e); vv[q] = __builtin_nontemporal_load((const f32x4*)p->in[3] + e); } }
          __builtin_amdgcn_sched_barrier(0);
#pragma unroll
          for (int q = 0; q < 4; ++q) { const int e = e0 + q * nb * 512; if (e < 4194304) { const int b = e >> 18, rem = e & 262143, r = rem >> 7, c4 = rem & 127; const size_t o = ((size_t)(b * SKV + r) * 512 + c4 * 4);
              u32x2 w; w.x = cvtpk(kv[q][0], kv[q][1]); w.y = cvtpk(kv[q][2], kv[q][3]); *(u32x2*)(KS + o) = w; w.x = cvtpk(vv[q][0], vv[q][1]); w.y = cvtpk(vv[q][2], vv[q][3]); *(u32x2*)(VS + o) = w; } } }
      const u32x4 z4 = {0u, 0u, 0u, 0u};
      for (int e = bid * 512 + tid; e < 245760; e += nb * 512) { const int b = e / 15360, rem = e % 15360, r = 2064 + (rem >> 6), c = (rem & 63) * 8; const size_t o = ((size_t)(b * SKV + r) * 512 + c);
          *(u32x4*)(KS + o) = z4; *(u32x4*)(VS + o) = z4; }
      u32x4* QS = (u32x4*)(p->ws + WS_QS);
      for (int e = bid * 512 + tid; e < 262144; e += nb * 512) QS[e] = z4; }
}

__device__ __forceinline__ void cumsum_unit(KP p, int cu, unsigned char* lds, const int mk_wid) {
    const int wid = mk_wid, tid = mk_tid(mk_wid), lane = tid & 63;
    float* wt = (float*)lds;
    const bool samp = cu >= 4; const int b = samp ? cu - 4 : cu; const int L = samp ? SKV : SEQ; const int nthr = L / 16;
    const float* src = nullptr;
    if (tid < nthr) { const int t0 = tid * 16;
        if (!samp) src = p->out + O_LFP + (size_t)(b * SEQ + t0) * 8;
        else if (t0 < PAST) src = p->in[4] + (size_t)(b * PAST + t0) * 8;
        else if (t0 < PAST + 16) src = p->out + O_LFS + (size_t)(b * 16) * 8; }
    float tot[8];
#pragma unroll
    for (int h = 0; h < 8; ++h) tot[h] = 0.f;
    if (src) {
#pragma unroll 4
        for (int r = 0; r < 16; ++r) { const f32x4 a = *(const f32x4*)(src + r * 8), c = *(const f32x4*)(src + r * 8 + 4);
            tot[0] += a[0]; tot[1] += a[1]; tot[2] += a[2]; tot[3] += a[3]; tot[4] += c[0]; tot[5] += c[1]; tot[6] += c[2]; tot[7] += c[3]; } }
    float pre[8];
#pragma unroll
    for (int h = 0; h < 8; ++h) { float v = tot[h];
#pragma unroll
        for (int o = 1; o < 64; o <<= 1) { const float t = __shfl_up(v, o); if (lane >= o) v += t; }
        pre[h] = v - tot[h];
        if (lane == 63) wt[wid * 8 + h] = v; }
    __syncthreads();
#pragma unroll
    for (int h = 0; h < 8; ++h) { float s = 0.f; for (int w = 0; w < wid; ++w) s += wt[w * 8 + h]; pre[h] += s; }
    if (tid < nthr) { float* G = (float*)(p->ws + (samp ? WS_GCS : WS_GCP)) + (size_t)(b * 8) * L + tid * 16;
#pragma unroll
        for (int q = 0; q < 4; ++q) { f32x4 o[8];
#pragma unroll
            for (int r = 0; r < 4; ++r) { f32x4 a = {0.f, 0.f, 0.f, 0.f}, c = a; if (src) { a = *(const f32x4*)(src + (q * 4 + r) * 8); c = *(const f32x4*)(src + (q * 4 + r) * 8 + 4); }
                pre[0] += a[0]; pre[1] += a[1]; pre[2] += a[2]; pre[3] += a[3]; pre[4] += c[0]; pre[5] += c[1]; pre[6] += c[2]; pre[7] += c[3];
#pragma unroll
                for (int h = 0; h < 8; ++h) o[h][r] = pre[h]; }
#pragma unroll
            for (int h = 0; h < 8; ++h) *(f32x4*)(G + (size_t)h * L + q * 4) = o[h]; } }
    __syncthreads();
}

__device__ __forceinline__ void norm_unit(KP p, int nu, const int mk_wid) {
    const int wid = mk_wid, tid = mk_tid(mk_wid), lane = tid & 63;
    const bool samp = nu >= 128; const int b = samp ? (nu - 128) / 9 : nu >> 5, rb = samp ? (nu - 128) % 9 : nu & 31;
    const bf16_t* Kp = samp ? (const bf16_t*)(p->ws + WS_KS) + (size_t)(b * SKV + 256 * rb + 32 * wid) * 512 : (const bf16_t*)(p->ws + WS_KP) + (size_t)(b * SEQ + 256 * rb + 32 * wid) * 512;
    const bf16_t* Qp = samp ? (const bf16_t*)(p->ws + WS_QS) + (size_t)(b * 256 + 32 * wid) * 512 : (const bf16_t*)(p->ws + WS_QP) + (size_t)(b * SEQ + 256 * rb + 32 * wid) * 512;
    const bool hasq = !samp || rb == 0;
    unsigned* NRM = (unsigned*)(p->ws + WS_CTL) + 512 + ((samp ? 32 : 0) + b * 8) * 2;
    float kmax = 0.f, qmax = 0.f;
#pragma unroll 8
    for (int r = 0; r < 32; ++r) { const u32x4 kw = *(const u32x4*)(Kp + (size_t)r * 512 + lane * 8); u32x4 qw = {0u, 0u, 0u, 0u}; if (hasq) qw = *(const u32x4*)(Qp + (size_t)r * 512 + lane * 8);
        float k2 = bflo(kw.x) * bflo(kw.x) + bfhi(kw.x) * bfhi(kw.x) + bflo(kw.y) * bflo(kw.y) + bfhi(kw.y) * bfhi(kw.y) + bflo(kw.z) * bflo(kw.z) + bfhi(kw.z) * bfhi(kw.z) + bflo(kw.w) * bflo(kw.w) + bfhi(kw.w) * bfhi(kw.w);
        float q2 = bflo(qw.x) * bflo(qw.x) + bfhi(qw.x) * bfhi(qw.x) + bflo(qw.y) * bflo(qw.y) + bfhi(qw.y) * bfhi(qw.y) + bflo(qw.z) * bflo(qw.z) + bfhi(qw.z) * bfhi(qw.z) + bflo(qw.w) * bflo(qw.w) + bfhi(qw.w) * bfhi(qw.w);
        k2 += __shfl_xor(k2, 1); k2 += __shfl_xor(k2, 2); k2 += __shfl_xor(k2, 4); q2 += __shfl_xor(q2, 1); q2 += __shfl_xor(q2, 2); q2 += __shfl_xor(q2, 4);
        kmax = fmaxf(kmax, k2); qmax = fmaxf(qmax, q2); }
    if ((lane & 7) == 0) { const int h = lane >> 3; atomicMax(NRM + h * 2 + 1, __float_as_uint(kmax)); if (hasq) atomicMax(NRM + h * 2, __float_as_uint(qmax)); }
}

__device__ __forceinline__ void sdesc(int u, int k, int& b, int& h, int& zrow0, int& tt0, int& nvalid, int& cid, bool& samp) {
    if (u < 1024) { const int bh = u >> 5, chunk = 4 * (u & 31) + k; b = bh >> 3; h = bh & 7; zrow0 = b * SEQ + 64 * chunk; tt0 = 64 * chunk; nvalid = 64; cid = bh * 128 + chunk; samp = false; }
    else { const int bh = 4 * (u - 1024) + k; b = bh >> 3; h = bh & 7; zrow0 = NPROMPT + b * 16; tt0 = 0; nvalid = 16; cid = 4096 + bh; samp = true; }
}
__device__ __forceinline__ void g1_unit(KP p, int u, unsigned char* lds, const int mk_wid) {
    const int wid = mk_wid, tid = mk_tid(mk_wid), lane = tid & 63;
    bf16_t* KB = (bf16_t*)lds;
    bf16_t* VB = (bf16_t*)(lds + 36864);
    float* LM = (float*)(lds + 73728);
    float* GC = (float*)(lds + 139264);
    float* BT = GC + 256; float* EG = BT + 256;
    const bf16_t* ZC = (const bf16_t*)(p->ws + WS_ZC);
    bf16_t* qG = (bf16_t*)(p->ws + WS_QG); bf16_t* kG = (bf16_t*)(p->ws + WS_KG); bf16_t* kTG = (bf16_t*)(p->ws + WS_KTG); bf16_t* wG = (bf16_t*)(p->ws + WS_WG); bf16_t* uTG = (bf16_t*)(p->ws + WS_UTG);
    float* gcG = (float*)(p->ws + WS_GCG); const float* GB = (const float*)(p->ws + WS_GB);
    { const int cg8 = tid & 7, tg = tid >> 3, slot = tg >> 4, c0 = 4 * (tg & 15);
      int b, h, zrow0, tt0, nvalid, cid; bool samp; sdesc(u, slot, b, h, zrow0, tt0, nvalid, cid, samp);
      u32x4 zr[3][7];
#pragma unroll
      for (int sec = 0; sec < 3; ++sec)
#pragma unroll
          for (int d = 0; d < 7; ++d) { const int cc = c0 - 3 + d; zr[sec][d] = (u32x4){0u, 0u, 0u, 0u};
              if (c0 < nvalid && tt0 + cc >= 0) zr[sec][d] = *(const u32x4*)(ZC + (size_t)(zrow0 + cc) * 1536 + sec * 512 + h * 64 + cg8 * 8); }
      __builtin_amdgcn_sched_barrier(0);
#pragma unroll
      for (int sec = 0; sec < 3; ++sec) {
          const int ch = sec * 512 + h * 64 + cg8 * 8; float o[4][8];
          if (c0 < nvalid) {
              float w[4][8], r[7][8];
#pragma unroll
              for (int i = 0; i < 4; ++i) { const f32x4 a = *(const f32x4*)(p->in[9] + i * 1536 + ch), c = *(const f32x4*)(p->in[9] + i * 1536 + ch + 4);
                  w[i][0] = a[0]; w[i][1] = a[1]; w[i][2] = a[2]; w[i][3] = a[3]; w[i][4] = c[0]; w[i][5] = c[1]; w[i][6] = c[2]; w[i][7] = c[3]; }
#pragma unroll
              for (int d = 0; d < 7; ++d) { const int cc = c0 - 3 + d, s = tt0 + cc;
                  if (s < 0) {
                      if (samp) { const float* cp = p->in[6] + (size_t)(b * 3 + 3 + s) * 1536 + ch; const f32x4 a = *(const f32x4*)cp, c = *(const f32x4*)(cp + 4);
                          r[d][0] = a[0]; r[d][1] = a[1]; r[d][2] = a[2]; r[d][3] = a[3]; r[d][4] = c[0]; r[d][5] = c[1]; r[d][6] = c[2]; r[d][7] = c[3]; }
                      else {
#pragma unroll
                          for (int e = 0; e < 8; ++e) r[d][e] = 0.f; }
                  } else { const u32x4 z = zr[sec][d];
                      r[d][0] = bflo(z.x); r[d][1] = bfhi(z.x); r[d][2] = bflo(z.y); r[d][3] = bfhi(z.y); r[d][4] = bflo(z.z); r[d][5] = bfhi(z.z); r[d][6] = bflo(z.w); r[d][7] = bfhi(z.w); } }
#pragma unroll
              for (int t = 0; t < 4; ++t)
#pragma unroll
                  for (int e = 0; e < 8; ++e) { const float y = w[0][e] * r[t][e] + w[1][e] * r[t + 1][e] + w[2][e] * r[t + 2][e] + w[3][e] * r[t + 3][e]; o[t][e] = y * sigmoidf_(y); }
          } else {
#pragma unroll
              for (int t = 0; t < 4; ++t)
#pragma unroll
                  for (int e = 0; e < 8; ++e) o[t][e] = 0.f; }
#pragma unroll
          for (int t = 0; t < 4; ++t) {
              float sc = 1.f;
              if (sec < 2) { float ss = 0.f;
#pragma unroll
                  for (int e = 0; e < 8; ++e) ss += o[t][e] * o[t][e];
                  ss += __shfl_xor(ss, 1); ss += __shfl_xor(ss, 2); ss += __shfl_xor(ss, 4);
                  sc = rsqrtf(ss + EPS) * (sec == 0 ? 0.125f : 1.0f); }
              u32x4 wv; wv.x = cvtpk(o[t][0] * sc, o[t][1] * sc); wv.y = cvtpk(o[t][2] * sc, o[t][3] * sc); wv.z = cvtpk(o[t][4] * sc, o[t][5] * sc); wv.w = cvtpk(o[t][6] * sc, o[t][7] * sc);
              const int c = c0 + t;
              if (sec == 0) *(u32x4*)(qG + (size_t)cid * 4096 + c * 64 + cg8 * 8) = wv;
              else if (sec == 1) { *(u32x4*)(KB + (slot * 64 + c) * 72 + cg8 * 8) = wv; *(u32x4*)(kG + (size_t)cid * 4096 + c * 64 + cg8 * 8) = wv; }
              else *(u32x4*)(VB + (slot * 64 + c) * 72 + cg8 * 8) = wv; } } }
    if (tid < 256) { int b, h, zrow0, tt0, nvalid, cid; bool samp; sdesc(u, wid, b, h, zrow0, tt0, nvalid, cid, samp);
        float g = 0.f, bt = 0.f; if (lane < nvalid) { g = GB[(size_t)(zrow0 + lane) * 16 + h]; bt = GB[(size_t)(zrow0 + lane) * 16 + 8 + h]; }
#pragma unroll
        for (int o = 1; o < 64; o <<= 1) { const float t = __shfl_up(g, o); if (lane >= o) g += t; }
        GC[wid * 64 + lane] = g; BT[wid * 64 + lane] = bt; EG[wid * 64 + lane] = __expf(g); gcG[(size_t)cid * 64 + lane] = g; }
    __syncthreads();
    const int slot3 = tid >> 7, col = tid & 127;
    int b3, h3, zrow3, tt3, nv3, cid3; bool samp3; sdesc(u, slot3, b3, h3, zrow3, tt3, nv3, cid3, samp3);
    float x[64];
    if (col < 64) {
#pragma unroll
        for (int i = 0; i < 64; ++i) x[i] = (i < nv3) ? bf2f(VB[(slot3 * 64 + i) * 72 + col]) * BT[slot3 * 64 + i] : 0.f;
    } else { const int dk = col - 64; const float glast = GC[slot3 * 64 + 63];
#pragma unroll
        for (int i8 = 0; i8 < 8; ++i8) { float kt[8];
#pragma unroll
            for (int e = 0; e < 8; ++e) { const int i = i8 * 8 + e; const float kv = bf2f(KB[(slot3 * 64 + i) * 72 + dk]); x[i] = kv * BT[slot3 * 64 + i] * EG[slot3 * 64 + i]; kt[e] = kv * __expf(glast - GC[slot3 * 64 + i]); }
            u32x4 wv; wv.x = cvtpk(kt[0], kt[1]); wv.y = cvtpk(kt[2], kt[3]); wv.z = cvtpk(kt[4], kt[5]); wv.w = cvtpk(kt[6], kt[7]);
            *(u32x4*)(kTG + (size_t)cid3 * 4096 + dk * 64 + i8 * 8) = wv; } }
    { const int slotw = wid >> 1, half = wid & 1, g = lane >> 4, r16 = lane & 15;
      int nvw, d0_, d1_, d2_, d3_, d4_; bool d5_; sdesc(u, slotw, d0_, d1_, d2_, d3_, nvw, d4_, d5_);
      for (int it = 2 * half; it < 2 * half + 2; ++it)
          for (int jt = 0; jt <= it && 16 * it < nvw; ++jt) { f32x4 acc = {0.f, 0.f, 0.f, 0.f};
#pragma unroll
              for (int ks = 0; ks < 2; ++ks) { const bf16x8 a = *(const bf16x8*)(KB + (slotw * 64 + 16 * it + r16) * 72 + 32 * ks + 8 * g), bb = *(const bf16x8*)(KB + (slotw * 64 + 16 * jt + r16) * 72 + 32 * ks + 8 * g);
                  acc = MFMA16(a, bb, acc); }
              const int j = 16 * jt + r16; const float gcj = GC[slotw * 64 + j];
#pragma unroll
              for (int r = 0; r < 4; ++r) { const int i = 16 * it + 4 * g + r; LM[(slotw * 64 + i) * 64 + j] = (i > j) ? acc[r] * BT[slotw * 64 + i] * __expf(GC[slotw * 64 + i] - gcj) : 0.f; } } }
    __syncthreads();
    { const float* Lr = LM + slot3 * 4096;
#pragma unroll
      for (int i = 1; i < 64; ++i) if (i < nv3) { float a = x[i];
#pragma unroll
          for (int j4 = 0; j4 < (i + 3) / 4; ++j4) { const f32x4 lv = *(const f32x4*)(Lr + i * 64 + 4 * j4);
#pragma unroll
              for (int e = 0; e < 4; ++e) if (4 * j4 + e < i) a -= lv[e] * x[4 * j4 + e]; }
          x[i] = a; } }
    if (col < 64) {
#pragma unroll
        for (int i8 = 0; i8 < 8; ++i8) { u32x4 wv; wv.x = cvtpk(x[i8 * 8], x[i8 * 8 + 1]); wv.y = cvtpk(x[i8 * 8 + 2], x[i8 * 8 + 3]); wv.z = cvtpk(x[i8 * 8 + 4], x[i8 * 8 + 5]); wv.w = cvtpk(x[i8 * 8 + 6], x[i8 * 8 + 7]);
            *(u32x4*)(uTG + (size_t)cid3 * 4096 + col * 64 + i8 * 8) = wv; }
    } else { const int dk = col - 64;
#pragma unroll
        for (int i = 0; i < 64; i += 2) { const unsigned w2 = cvtpk(x[i], x[i + 1]); VB[(slot3 * 64 + i) * 72 + dk] = (bf16_t)(w2 & 0xffffu); VB[(slot3 * 64 + i + 1) * 72 + dk] = (bf16_t)(w2 >> 16); } }
    __syncthreads();
#pragma unroll
    for (int q = 0; q < 4; ++q) { const int piece = tid + 512 * q, slotc = piece >> 9, rem = piece & 511, c = rem >> 3, pc = rem & 7;
        int b, h, zrow0, tt0, nvalid, cid; bool samp; sdesc(u, slotc, b, h, zrow0, tt0, nvalid, cid, samp);
        *(u32x4*)(wG + (size_t)cid * 4096 + c * 64 + pc * 8) = *(const u32x4*)(VB + (slotc * 64 + c) * 72 + pc * 8); }
    __syncthreads();
}

__device__ __forceinline__ void g2_task(KP p, int cid0, int nchunks, int dv0, const float* s_init, float* s_out, int lane) {
    const int g = lane >> 4, r16 = lane & 15;
    const bf16_t* wG = (const bf16_t*)(p->ws + WS_WG); const bf16_t* kTG = (const bf16_t*)(p->ws + WS_KTG); const bf16_t* uTG = (const bf16_t*)(p->ws + WS_UTG); const float* gcG = (const float*)(p->ws + WS_GCG);
    bf16_t* vnT = (bf16_t*)(p->ws + WS_VNT); bf16_t* ST = (bf16_t*)(p->ws + WS_ST);
    f32x4 S[4];
#pragma unroll
    for (int mt = 0; mt < 4; ++mt)
#pragma unroll
        for (int r = 0; r < 4; ++r) S[mt][r] = s_init ? s_init[(16 * mt + 4 * g + r) * 64 + dv0 + r16] : 0.f;
#define G2_LOAD(UU, AW, AK, GL, n_) do { const size_t cb_ = (size_t)(cid0 + (n_)) * 4096; const bf16_t* wp = wG + cb_; const bf16_t* kp = kTG + cb_; const bf16_t* up = uTG + cb_ + (dv0 + r16) * 64; \
        _Pragma("unroll") for (int mt = 0; mt < 4; ++mt) { UU[mt] = *(const u32x2*)(up + 16 * mt + 4 * g); \
            _Pragma("unroll") for (int ks = 0; ks < 2; ++ks) { AW[mt][ks] = ld2x8(wp + (16 * mt + r16) * 64 + 32 * ks + 4 * g, wp + (16 * mt + r16) * 64 + 32 * ks + 16 + 4 * g); \
                AK[mt][ks] = ld2x8(kp + (16 * mt + r16) * 64 + 32 * ks + 4 * g, kp + (16 * mt + r16) * 64 + 32 * ks + 16 + 4 * g); } } \
        GL = gcG[(size_t)(cid0 + (n_)) * 64 + 63]; } while (0)
#define G2_STEP(UU, AW, AK, GL, n_) do { const size_t cb = (size_t)(cid0 + (n_)) * 4096; f32x4 acc[4]; \
        _Pragma("unroll") for (int mt = 0; mt < 4; ++mt) acc[mt] = (f32x4){bflo(UU[mt].x), bfhi(UU[mt].x), bflo(UU[mt].y), bfhi(UU[mt].y)}; \
        const float eg = __expf(GL); \
        _Pragma("unroll") for (int mt = 0; mt < 4; ++mt) { u32x2 w; w.x = cvtpk(S[mt][0], S[mt][1]); w.y = cvtpk(S[mt][2], S[mt][3]); *(u32x2*)(ST + cb + (dv0 + r16) * 64 + 16 * mt + 4 * g) = w; } \
        bf16x8 Bs[2]; \
        _Pragma("unroll") for (int ks = 0; ks < 2; ++ks) Bs[ks] = __builtin_bit_cast(bf16x8, pack8(-S[2 * ks], -S[2 * ks + 1])); \
        _Pragma("unroll") for (int mt = 0; mt < 4; ++mt) _Pragma("unroll") for (int ks = 0; ks < 2; ++ks) acc[mt] = MFMA16(AW[mt][ks], Bs[ks], acc[mt]); \
        _Pragma("unroll") for (int mt = 0; mt < 4; ++mt) { u32x2 w; w.x = cvtpk(acc[mt][0], acc[mt][1]); w.y = cvtpk(acc[mt][2], acc[mt][3]); *(u32x2*)(vnT + cb + (dv0 + r16) * 64 + 16 * mt + 4 * g) = w; } \
        bf16x8 Bv[2]; \
        _Pragma("unroll") for (int ks = 0; ks < 2; ++ks) Bv[ks] = __builtin_bit_cast(bf16x8, pack8(acc[2 * ks], acc[2 * ks + 1])); \
        _Pragma("unroll") for (int mt = 0; mt < 4; ++mt) { S[mt] = S[mt] * eg; \
            _Pragma("unroll") for (int ks = 0; ks < 2; ++ks) S[mt] = MFMA16(AK[mt][ks], Bv[ks], S[mt]); } } while (0)
    u32x2 uA[4], uB[4]; bf16x8 wA[4][2], kA[4][2], wB[4][2], kB[4][2]; float gA, gB;
    G2_LOAD(uA, wA, kA, gA, 0);
    __builtin_amdgcn_sched_barrier(0);
    for (int n = 0; n < nchunks; n += 2) {
        { const int n1 = (n + 1 < nchunks) ? n + 1 : nchunks - 1; G2_LOAD(uB, wB, kB, gB, n1); }
        __builtin_amdgcn_sched_barrier(0);
        G2_STEP(uA, wA, kA, gA, n);
        __builtin_amdgcn_sched_barrier(0);
        { const int n2 = (n + 2 < nchunks) ? n + 2 : nchunks - 1; G2_LOAD(uA, wA, kA, gA, n2); }
        __builtin_amdgcn_sched_barrier(0);
        if (n + 1 < nchunks) G2_STEP(uB, wB, kB, gB, n + 1);
        __builtin_amdgcn_sched_barrier(0);
    }
#undef G2_LOAD
#undef G2_STEP
#pragma unroll
    for (int mt = 0; mt < 4; ++mt)
#pragma unroll
        for (int r = 0; r < 4; ++r) s_out[(16 * mt + 4 * g + r) * 64 + dv0 + r16] = S[mt][r];
}

__device__ __forceinline__ void g2_scan_lds(KP p, int s, int dv0, float* s_out, int lane, unsigned char* lds) {
    const int g = lane >> 4, r16 = lane & 15;
    const bf16_t* wG = (const bf16_t*)(p->ws + WS_WG); const bf16_t* kTG = (const bf16_t*)(p->ws + WS_KTG); const bf16_t* uTG = (const bf16_t*)(p->ws + WS_UTG); const float* gcG = (const float*)(p->ws + WS_GCG);
    bf16_t* vnT = (bf16_t*)(p->ws + WS_VNT); bf16_t* ST = (bf16_t*)(p->ws + WS_ST);
    bf16_t* Lw = (bf16_t*)lds; bf16_t* Lk = Lw + 64 * 72; bf16_t* Lu = Lk + 64 * 72;
    f32x4 S[4];
#pragma unroll
    for (int mt = 0; mt < 4; ++mt) S[mt] = (f32x4){0.f, 0.f, 0.f, 0.f};
    u32x4 rw[8], rk[8], ru[2]; float gl;
#define G2L_LOAD(n_) do { const size_t cb_ = (size_t)(s * 128 + (n_)) * 4096; \
        _Pragma("unroll") for (int q = 0; q < 8; ++q) { rw[q] = *(const u32x4*)(wG + cb_ + (size_t)(lane + 64 * q) * 8); rk[q] = *(const u32x4*)(kTG + cb_ + (size_t)(lane + 64 * q) * 8); } \
        _Pragma("unroll") for (int q = 0; q < 2; ++q) ru[q] = *(const u32x4*)(uTG + cb_ + (size_t)dv0 * 64 + (size_t)(lane + 64 * q) * 8); \
        gl = gcG[(size_t)(s * 128 + (n_)) * 64 + 63]; } while (0)
    G2L_LOAD(0);
    for (int n = 0; n < 128; ++n) { const size_t cb = (size_t)(s * 128 + n) * 4096;
#pragma unroll
        for (int q = 0; q < 8; ++q) { const int piece = lane + 64 * q; *(u32x4*)(Lw + (piece >> 3) * 72 + (piece & 7) * 8) = rw[q]; *(u32x4*)(Lk + (piece >> 3) * 72 + (piece & 7) * 8) = rk[q]; }
#pragma unroll
        for (int q = 0; q < 2; ++q) { const int piece = lane + 64 * q; *(u32x4*)(Lu + (piece >> 3) * 72 + (piece & 7) * 8) = ru[q]; }
        const float eg = __expf(gl);
        __builtin_amdgcn_sched_barrier(0);
        { const int n1 = n + 1 < 128 ? n + 1 : 127; G2L_LOAD(n1); }
        __builtin_amdgcn_sched_barrier(0);
        f32x4 acc[4];
#pragma unroll
        for (int mt = 0; mt < 4; ++mt) { const u32x2 uu = *(const u32x2*)(Lu + r16 * 72 + 16 * mt + 4 * g); acc[mt] = (f32x4){bflo(uu.x), bfhi(uu.x), bflo(uu.y), bfhi(uu.y)}; }
#pragma unroll
        for (int mt = 0; mt < 4; ++mt) { u32x2 w; w.x = cvtpk(S[mt][0], S[mt][1]); w.y = cvtpk(S[mt][2], S[mt][3]); *(u32x2*)(ST + cb + (dv0 + r16) * 64 + 16 * mt + 4 * g) = w; }
        bf16x8 Bs[2];
#pragma unroll
        for (int ks = 0; ks < 2; ++ks) Bs[ks] = __builtin_bit_cast(bf16x8, pack8(-S[2 * ks], -S[2 * ks + 1]));
#pragma unroll
        for (int mt = 0; mt < 4; ++mt)
#pragma unroll
            for (int ks = 0; ks < 2; ++ks) acc[mt] = MFMA16(ld2x8(Lw + (16 * mt + r16) * 72 + 32 * ks + 4 * g, Lw + (16 * mt + r16) * 72 + 32 * ks + 16 + 4 * g), Bs[ks], acc[mt]);
#pragma unroll
        for (int mt = 0; mt < 4; ++mt) { u32x2 w; w.x = cvtpk(acc[mt][0], acc[mt][1]); w.y = cvtpk(acc[mt][2], acc[mt][3]); *(u32x2*)(vnT + cb + (dv0 + r16) * 64 + 16 * mt + 4 * g) = w; }
        bf16x8 Bv[2];
#pragma unroll
        for (int ks = 0; ks < 2; ++ks) Bv[ks] = __builtin_bit_cast(bf16x8, pack8(acc[2 * ks], acc[2 * ks + 1]));
#pragma unroll
        for (int mt = 0; mt < 4; ++mt) { S[mt] = S[mt] * eg;
#pragma unroll
            for (int ks = 0; ks < 2; ++ks) S[mt] = MFMA16(ld2x8(Lk + (16 * mt + r16) * 72 + 32 * ks + 4 * g, Lk + (16 * mt + r16) * 72 + 32 * ks + 16 + 4 * g), Bv[ks], S[mt]); }
        __builtin_amdgcn_sched_barrier(0);
    }
#undef G2L_LOAD
#pragma unroll
    for (int mt = 0; mt < 4; ++mt)
#pragma unroll
        for (int r = 0; r < 4; ++r) s_out[(16 * mt + 4 * g + r) * 64 + dv0 + r16] = S[mt][r];
}

__device__ __forceinline__ void phase3(KP p, unsigned char* lds, const int mk_wid) {
    using bf16 = attn_body::bf16;
    const int wid = mk_wid, tid = mk_tid(mk_wid), lane = tid & 63, bid = blockIdx.x;
    const int G = (int)gridDim.x;
    if (wid == 0) for (int task = bid; task < 128; task += G) { const int s = task >> 2; g2_scan_lds(p, s, 16 * (task & 3), p->out + O_SGP + (size_t)s * 4096, lane, lds); }
    { const int sb0 = G >= 192 ? 128 : 0;
      if (bid >= sb0) for (int wt = (bid - sb0) * 8 + wid; wt < 512; wt += (G - sb0) * 8) { const int s = wt >> 2; g2_task(p, 4096 + s, 1, 16 * (wt & 3), p->in[5] + (size_t)s * 4096, p->out + O_SGS + (size_t)s * 4096, lane); } }
    __syncthreads();
    unsigned* ctr = (unsigned*)(p->ws + WS_CTL);
    volatile int* sidx = (volatile int*)(lds + 120000);
    bf16* QP = (bf16*)(p->ws + WS_QP); const bf16* KP = (const bf16*)(p->ws + WS_KP); const bf16* VP = (const bf16*)(p->ws + WS_VP);
    const bf16* QS = (const bf16*)(p->ws + WS_QS); const bf16* KS = (const bf16*)(p->ws + WS_KS); const bf16* VS = (const bf16*)(p->ws + WS_VS);
    for (;;) {
        if (tid == 0) *sidx = (int)atomicAdd(ctr, 1u);
        __syncthreads(); const int idx = __builtin_amdgcn_readfirstlane(*sidx); __syncthreads();
        if (idx >= 1152) break;
        {
            int q0, nvalid; const bf16 *Qu, *Kh, *Vh; bf16* Ou; const float* G;
            int nidx;
            if (idx < 1024) { const int qb = 31 - (idx >> 5), bh = idx & 31, b = bh >> 3, h = bh & 7; q0 = qb * 256; nvalid = 256; nidx = bh;
                Ou = QP + ((size_t)(b * SEQ + q0) * 512 + h * 64); Qu = Ou; Kh = KP + ((size_t)b * SEQ * 512 + h * 64); Vh = VP + ((size_t)b * SEQ * 512 + h * 64); G = (const float*)(p->ws + WS_GCP) + (size_t)bh * SEQ; }
            else { const int bh = idx - 1024, b = bh >> 3, h = bh & 7; q0 = PAST; nvalid = 16; nidx = 32 + bh;
                Qu = QS + ((size_t)(b * 256) * 512 + h * 64); Kh = KS + ((size_t)b * SKV * 512 + h * 64); Vh = VS + ((size_t)b * SKV * 512 + h * 64);
                Ou = QP + ((size_t)(NPROMPT + b * 16) * 512 + h * 64); G = (const float*)(p->ws + WS_GCS) + (size_t)bh * SKV; }
            { const float* NR = (const float*)(p->ws + WS_CTL) + 512 + nidx * 2; const float thr = 41.0f + 2.02f * sqrtf(NR[0] * NR[1]);
              const int NTt = (q0 + 256) >> 6, tc = 2 * lane; const float gq = G[q0];
              bool ok = tc <= NTt - 4; if (ok && tc > 0) ok = (gq - G[64 * tc - 1]) * 1.4426950408889634f <= -thr;
              const unsigned long long mk = __ballot(ok); const int cnt = __builtin_amdgcn_readfirstlane((int)__ffsll((long long)~mk) - 1);
              const int t0 = 2 * (cnt > 0 ? cnt - 1 : 0);
              attn_body::attn_unit<60>(q0 - 64 * t0, nvalid, Qu, Kh + (size_t)t0 * 64 * 512, Vh + (size_t)t0 * 64 * 512, Ou, G + 64 * t0, (char*)lds, mk_wid); }
        }
    }
}

__device__ __forceinline__ void g3_task(KP p, int cid, int ib, int rowbase, int h, int lane) {
    const int g = lane >> 4, r16 = lane & 15, i = 16 * ib + r16; const size_t cb = (size_t)cid * 4096;
    const bf16_t* qG = (const bf16_t*)(p->ws + WS_QG) + cb; const bf16_t* kG = (const bf16_t*)(p->ws + WS_KG) + cb; const bf16_t* vnT = (const bf16_t*)(p->ws + WS_VNT) + cb; const bf16_t* ST = (const bf16_t*)(p->ws + WS_ST) + cb;
    const float* gc = (const float*)(p->ws + WS_GCG) + (size_t)cid * 64;
    bf16x8 Bq[2], Akk[4][2], Ast[4][2], Avn[4][2]; f32x4 gj[4];
#pragma unroll
    for (int ks = 0; ks < 2; ++ks) Bq[ks] = *(const bf16x8*)(qG + i * 64 + 32 * ks + 8 * g);
    const float gci = gc[i];
#pragma unroll
    for (int t4 = 0; t4 < 4; ++t4) { gj[t4] = *(const f32x4*)(gc + 16 * t4 + 4 * g);
#pragma unroll
        for (int ks = 0; ks < 2; ++ks) { Akk[t4][ks] = *(const bf16x8*)(kG + (16 * t4 + r16) * 64 + 32 * ks + 8 * g); Ast[t4][ks] = *(const bf16x8*)(ST + (16 * t4 + r16) * 64 + 32 * ks + 8 * g);
            Avn[t4][ks] = ld2x8(vnT + (16 * t4 + r16) * 64 + 32 * ks + 4 * g, vnT + (16 * t4 + r16) * 64 + 32 * ks + 16 + 4 * g); } }
    const size_t R = (size_t)(rowbase + i);
    const bf16_t* GG = (const bf16_t*)(p->ws + WS_GG) + R * 512 + h * 64; bf16_t* OG = (bf16_t*)(p->ws + WS_OG) + R * 512 + h * 64;
    u32x2 gw[4]; f32x4 ng[4];
#pragma unroll
    for (int mt = 0; mt < 4; ++mt) { gw[mt] = *(const u32x2*)(GG + 16 * mt + 4 * g); ng[mt] = *(const f32x4*)(p->in[12] + 16 * mt + 4 * g); }
    __builtin_amdgcn_sched_barrier(0);
    f32x4 P[4];
#pragma unroll
    for (int jt = 0; jt < 4; ++jt) { f32x4 acc = {0.f, 0.f, 0.f, 0.f};
#pragma unroll
        for (int ks = 0; ks < 2; ++ks) acc = MFMA16(Akk[jt][ks], Bq[ks], acc);
#pragma unroll
        for (int r = 0; r < 4; ++r) { const int j = 16 * jt + 4 * g + r; P[jt][r] = (j <= i) ? acc[r] * __expf(gci - gj[jt][r]) : 0.f; } }
    bf16x8 Bp[2];
#pragma unroll
    for (int ks = 0; ks < 2; ++ks) Bp[ks] = __builtin_bit_cast(bf16x8, pack8(P[2 * ks], P[2 * ks + 1]));
    const float egi = __expf(gci);
    f32x4 o[4]; float ss = 0.f;
#pragma unroll
    for (int mt = 0; mt < 4; ++mt) { f32x4 acc = {0.f, 0.f, 0.f, 0.f};
#pragma unroll
        for (int ks = 0; ks < 2; ++ks) acc = MFMA16(Ast[mt][ks], Bq[ks], acc);
        acc = acc * egi;
#pragma unroll
        for (int ks = 0; ks < 2; ++ks) acc = MFMA16(Avn[mt][ks], Bp[ks], acc);
        o[mt] = acc; ss += acc[0] * acc[0] + acc[1] * acc[1] + acc[2] * acc[2] + acc[3] * acc[3]; }
    ss += __shfl_xor(ss, 16); ss += __shfl_xor(ss, 32);
    const float rs = rsqrtf(ss * (1.0f / 64.0f) + EPS);
#pragma unroll
    for (int mt = 0; mt < 4; ++mt) {
        const float z0 = bflo(gw[mt].x), z1 = bfhi(gw[mt].x), z2 = bflo(gw[mt].y), z3 = bfhi(gw[mt].y);
        u32x2 w; w.x = cvtpk(o[mt][0] * rs * ng[mt][0] * z0 * sigmoidf_(z0), o[mt][1] * rs * ng[mt][1] * z1 * sigmoidf_(z1)); w.y = cvtpk(o[mt][2] * rs * ng[mt][2] * z2 * sigmoidf_(z2), o[mt][3] * rs * ng[mt][3] * z3 * sigmoidf_(z3));
        *(u32x2*)(OG + 16 * mt + 4 * g) = w; }
}
__device__ __forceinline__ void phase4(KP p, unsigned char* lds, const int mk_wid, const int nskip) {
    const int wid = mk_wid, tid = mk_tid(mk_wid), lane = tid & 63;
    const int half = wid >> 2, ib = wid & 3, t256 = tid & 255, g = lane >> 4, r16 = lane & 15;
    bf16_t* L = (bf16_t*)lds + half * (4 * 64 * 72);
    const bf16_t* Lq = L; const bf16_t* Lk = L + 64 * 72; const bf16_t* Ls = L + 2 * 64 * 72; const bf16_t* Lv = L + 3 * 64 * 72;
    u32x4 v[4][2];
#define G3_LOADV(pr_) do { const size_t cb_ = (size_t)(2 * (pr_) + half) * 4096; \
        const bf16_t* src_[4] = {(const bf16_t*)(p->ws + WS_QG) + cb_, (const bf16_t*)(p->ws + WS_KG) + cb_, (const bf16_t*)(p->ws + WS_ST) + cb_, (const bf16_t*)(p->ws + WS_VNT) + cb_}; \
        _Pragma("unroll") for (int a = 0; a < 4; ++a) _Pragma("unroll") for (int q = 0; q < 2; ++q) v[a][q] = *(const u32x4*)(src_[a] + (size_t)(t256 + 256 * q) * 8); } while (0)
    const int b4 = (int)blockIdx.x - nskip, nb4 = (int)gridDim.x - nskip;
    if (b4 < 0) return;
    if (b4 < 2112) G3_LOADV(b4);
    for (int pr = b4; pr < 2112; pr += nb4) {
        const int cid = 2 * pr + half; const bool samp = cid >= 4096;
        const int bh = samp ? cid - 4096 : cid >> 7, h = bh & 7;
        const int rowbase = samp ? NPROMPT + (bh >> 3) * 16 : (bh >> 3) * SEQ + 64 * (cid & 127);
#pragma unroll
        for (int a = 0; a < 4; ++a)
#pragma unroll
            for (int q = 0; q < 2; ++q) { const int piece = t256 + 256 * q; *(u32x4*)(L + (a * 64 + (piece >> 3)) * 72 + (piece & 7) * 8) = v[a][q]; }
        __syncthreads();
        if (pr + nb4 < 2112) G3_LOADV(pr + nb4);
        __builtin_amdgcn_sched_barrier(0);
        if (!samp || ib == 0) {
            const int i = 16 * ib + r16;
            const float* gc = (const float*)(p->ws + WS_GCG) + (size_t)cid * 64;
            const size_t R = (size_t)(rowbase + i);
            const bf16_t* GG = (const bf16_t*)(p->ws + WS_GG) + R * 512 + h * 64; bf16_t* OG = (bf16_t*)(p->ws + WS_OG) + R * 512 + h * 64;
            const float gci = gc[i]; f32x4 gj[4]; u32x2 gw[4]; f32x4 ng[4];
#pragma unroll
            for (int t4 = 0; t4 < 4; ++t4) { gj[t4] = *(const f32x4*)(gc + 16 * t4 + 4 * g); gw[t4] = *(const u32x2*)(GG + 16 * t4 + 4 * g); ng[t4] = *(const f32x4*)(p->in[12] + 16 * t4 + 4 * g); }
            bf16x8 Bq[2];
#pragma unroll
            for (int ks = 0; ks < 2; ++ks) Bq[ks] = *(const bf16x8*)(Lq + i * 72 + 32 * ks + 8 * g);
            f32x4 P[4];
#pragma unroll
            for (int jt = 0; jt < 4; ++jt) { f32x4 acc = {0.f, 0.f, 0.f, 0.f};
#pragma unroll
                for (int ks = 0; ks < 2; ++ks) acc = MFMA16(*(const bf16x8*)(Lk + (16 * jt + r16) * 72 + 32 * ks + 8 * g), Bq[ks], acc);
#pragma unroll
                for (int r = 0; r < 4; ++r) { const int j = 16 * jt + 4 * g + r; P[jt][r] = (j <= i) ? acc[r] * __expf(gci - gj[jt][r]) : 0.f; } }
            bf16x8 Bp[2];
#pragma unroll
            for (int ks = 0; ks < 2; ++ks) Bp[ks] = __builtin_bit_cast(bf16x8, pack8(P[2 * ks], P[2 * ks + 1]));
            const float egi = __expf(gci);
            f32x4 o[4]; float ss = 0.f;
#pragma unroll
            for (int mt = 0; mt < 4; ++mt) { f32x4 acc = {0.f, 0.f, 0.f, 0.f};
#pragma unroll
                for (int ks = 0; ks < 2; ++ks) acc = MFMA16(*(const bf16x8*)(Ls + (16 * mt + r16) * 72 + 32 * ks + 8 * g), Bq[ks], acc);
                acc = acc * egi;
#pragma unroll
                for (int ks = 0; ks < 2; ++ks) acc = MFMA16(ld2x8(Lv + (16 * mt + r16) * 72 + 32 * ks + 4 * g, Lv + (16 * mt + r16) * 72 + 32 * ks + 16 + 4 * g), Bp[ks], acc);
                o[mt] = acc; ss += acc[0] * acc[0] + acc[1] * acc[1] + acc[2] * acc[2] + acc[3] * acc[3]; }
            ss += __shfl_xor(ss, 16); ss += __shfl_xor(ss, 32);
            const float rs = rsqrtf(ss * (1.0f / 64.0f) + EPS);
#pragma unroll
            for (int mt = 0; mt < 4; ++mt) {
                const float z0 = bflo(gw[mt].x), z1 = bfhi(gw[mt].x), z2 = bflo(gw[mt].y), z3 = bfhi(gw[mt].y);
                u32x2 w; w.x = cvtpk(o[mt][0] * rs * ng[mt][0] * z0 * sigmoidf_(z0), o[mt][1] * rs * ng[mt][1] * z1 * sigmoidf_(z1)); w.y = cvtpk(o[mt][2] * rs * ng[mt][2] * z2 * sigmoidf_(z2), o[mt][3] * rs * ng[mt][3] * z3 * sigmoidf_(z3));
                *(u32x2*)(OG + 16 * mt + 4 * g) = w; }
        }
        __syncthreads();
    }
#undef G3_LOADV
}

__device__ __forceinline__ void phase7(KP p, const int mk_wid) {
    const int wid = mk_wid, tid = mk_tid(mk_wid), lane = tid & 63;
    const float* MIX = (const float*)(p->ws + WS_MIX); const float* RS1 = (const float*)(p->ws + WS_RS1); bf16_t* XN2 = (bf16_t*)(p->ws + WS_XN2);
    const int rstep = gridDim.x * 8;
    for (int rowa = blockIdx.x * 8 + wid; rowa < NPROMPT; rowa += 2 * rstep) {
        int rows[2]; rows[0] = rowa; rows[1] = rowa + rstep < NPROMPT ? rowa + rstep : rowa;
        f32x4 xv[2][4], mv[2][4]; float q1[2];
#pragma unroll
        for (int q = 0; q < 2; ++q) { const int row = rows[q]; const float* xr = p->in[0] + (size_t)row * 1024;
            q1[q] = RS1[(size_t)row * 16 + (lane & 15)];
#pragma unroll
            for (int i = 0; i < 4; ++i) { const int c = lane * 4 + 256 * i; xv[q][i] = __builtin_nontemporal_load((const f32x4*)(xr + c)); const u32x2 mw = __builtin_nontemporal_load((const u32x2*)((const bf16_t*)MIX + (size_t)row * 1024 + c)); mv[q][i] = (f32x4){bflo(mw.x), bfhi(mw.x), bflo(mw.y), bfhi(mw.y)}; } }
        __builtin_amdgcn_sched_barrier(0);
#pragma unroll
        for (int q = 0; q < 2; ++q) { const int row = rows[q]; float qq = q1[q]; qq += __shfl_xor(qq, 8); qq += __shfl_xor(qq, 4); qq += __shfl_xor(qq, 2); qq += __shfl_xor(qq, 1);
            const float rs1 = rsqrtf(qq * (1.0f / 1024.0f) + EPS);
            f32x4 v[4]; float ss = 0.f;
#pragma unroll
            for (int i = 0; i < 4; ++i) { const int c = lane * 4 + 256 * i; const f32x4 g = *(const f32x4*)(p->in[17] + c);
                v[i] = xv[q][i] + mv[q][i] * rs1 * g; ss += v[i][0] * v[i][0] + v[i][1] * v[i][1] + v[i][2] * v[i][2] + v[i][3] * v[i][3];
                *(f32x4*)(p->out + O_Y + (size_t)row * 1024 + c) = v[i]; }
            ss = wave_sum(ss); const float rs2 = rsqrtf(ss * (1.0f / 1024.0f) + EPS);
#pragma unroll
            for (int i = 0; i < 4; ++i) { const int c = lane * 4 + 256 * i; const f32x4 g = *(const f32x4*)(p->in[18] + c); const f32x4 y = v[i] * rs2 * g;
                u32x2 w; w.x = cvtpk(y[0], y[1]); w.y = cvtpk(y[2], y[3]); *(u32x2*)(XN2 + (size_t)row * 1024 + c) = w; } } }
    { const float* MP = (const float*)(p->ws + WS_DOWNP);
      for (int sr = blockIdx.x * 8 + wid; sr < NSAMP; sr += rstep) { f32x4 m[4]; float qq = 0.f;
#pragma unroll
          for (int i = 0; i < 4; ++i) { const size_t o = (size_t)sr * 1024 + lane * 4 + 256 * i;
              m[i] = ((*(const f32x4*)(MP + o) + *(const f32x4*)(MP + 262144 + o)) + *(const f32x4*)(MP + 2 * 262144 + o)) + *(const f32x4*)(MP + 3 * 262144 + o);
              qq += m[i][0] * m[i][0] + m[i][1] * m[i][1] + m[i][2] * m[i][2] + m[i][3] * m[i][3]; }
          qq = wave_sum(qq); const float rs1 = rsqrtf(qq * (1.0f / 1024.0f) + EPS); const int row = NPROMPT + sr;
          f32x4 v[4]; float ss = 0.f;
#pragma unroll
          for (int i = 0; i < 4; ++i) { const int c = lane * 4 + 256 * i; const f32x4 x = *(const f32x4*)(p->in[1] + (size_t)sr * 1024 + c), g = *(const f32x4*)(p->in[17] + c);
              v[i] = x + m[i] * rs1 * g; ss += v[i][0] * v[i][0] + v[i][1] * v[i][1] + v[i][2] * v[i][2] + v[i][3] * v[i][3];
              *(f32x4*)(p->out + O_Y + (size_t)row * 1024 + c) = v[i]; }
          ss = wave_sum(ss); const float rs2 = rsqrtf(ss * (1.0f / 1024.0f) + EPS);
#pragma unroll
          for (int i = 0; i < 4; ++i) { const int c = lane * 4 + 256 * i; const f32x4 g = *(const f32x4*)(p->in[18] + c); const f32x4 y = v[i] * rs2 * g;
              u32x2 w; w.x = cvtpk(y[0], y[1]); w.y = cvtpk(y[2], y[3]); *(u32x2*)(XN2 + (size_t)row * 1024 + c) = w; } } }
}
__device__ __forceinline__ void phase10(KP p, const int mk_wid) {
    const int wid = mk_wid, tid = mk_tid(mk_wid), lane = tid & 63;
    const float* DN = (const float*)(p->ws + WS_DOWN); const float* RS2 = (const float*)(p->ws + WS_RS2); const float* DP = (const float*)(p->ws + WS_DOWNP);
    const int rstep = gridDim.x * 8;
    for (int rowa = blockIdx.x * 8 + wid; rowa < NPROMPT; rowa += 2 * rstep) {
        const int nr = rowa + rstep < NPROMPT ? 2 : 1;
        f32x4 xv[2][4], dv[2][4]; float q2[2];
#pragma unroll
        for (int q = 0; q < 2; ++q) { const int row = q < nr ? rowa + q * rstep : rowa; q2[q] = RS2[(size_t)row * 16 + (lane & 15)];
#pragma unroll
            for (int i = 0; i < 4; ++i) { const int c = lane * 4 + 256 * i; xv[q][i] = __builtin_nontemporal_load((const f32x4*)(p->out + O_Y + (size_t)row * 1024 + c)); const u32x2 dw = __builtin_nontemporal_load((const u32x2*)((const bf16_t*)DN + (size_t)row * 1024 + c)); dv[q][i] = (f32x4){bflo(dw.x), bfhi(dw.x), bflo(dw.y), bfhi(dw.y)}; } }
        __builtin_amdgcn_sched_barrier(0);
#pragma unroll
        for (int q = 0; q < 2; ++q) if (q < nr) { const int row = rowa + q * rstep; float qq = q2[q]; qq += __shfl_xor(qq, 8); qq += __shfl_xor(qq, 4); qq += __shfl_xor(qq, 2); qq += __shfl_xor(qq, 1);
            const float rs = rsqrtf(qq * (1.0f / 1024.0f) + EPS);
#pragma unroll
            for (int i = 0; i < 4; ++i) { const int c = lane * 4 + 256 * i; const f32x4 g = *(const f32x4*)(p->in[19] + c);
                __builtin_nontemporal_store(xv[q][i] + dv[q][i] * rs * g, (f32x4*)(p->out + O_Y + (size_t)row * 1024 + c)); } } }
    for (int sr = blockIdx.x * 8 + wid; sr < NSAMP; sr += rstep) { f32x4 d[4]; float ss = 0.f;
#pragma unroll
        for (int i = 0; i < 4; ++i) { const int c = lane * 4 + 256 * i; const size_t o = (size_t)sr * 1024 + c;
            d[i] = ((*(const f32x4*)(DP + o) + *(const f32x4*)(DP + 262144 + o)) + *(const f32x4*)(DP + 2 * 262144 + o)) + *(const f32x4*)(DP + 3 * 262144 + o);
            ss += d[i][0] * d[i][0] + d[i][1] * d[i][1] + d[i][2] * d[i][2] + d[i][3] * d[i][3]; }
        ss = wave_sum(ss); const float rs = rsqrtf(ss * (1.0f / 1024.0f) + EPS);
#pragma unroll
        for (int i = 0; i < 4; ++i) { const int c = lane * 4 + 256 * i; float* yp = p->out + O_Y + (size_t)(NPROMPT + sr) * 1024 + c; const f32x4 g = *(const f32x4*)(p->in[19] + c);
            *(f32x4*)yp = *(const f32x4*)yp + d[i] * rs * g; } }
}

__device__ __forceinline__ void gbar(unsigned* cnt, unsigned nblocks, const int mk_wid) {
    __syncthreads();
    if (mk_tid(mk_wid) == 0) {
        __builtin_amdgcn_fence(__ATOMIC_RELEASE, "agent");
        const unsigned grp = blockIdx.x & 7u, gsize = (nblocks + 7u - grp) >> 3, ngrp = nblocks < 8u ? nblocks : 8u;
        if (__hip_atomic_fetch_add(cnt + 32u * (grp + 1u), 1u, __ATOMIC_RELAXED, __HIP_MEMORY_SCOPE_AGENT) + 1u == gsize) {
            __builtin_amdgcn_fence(__ATOMIC_SEQ_CST, "agent");
            __hip_atomic_fetch_add(cnt, 1u, __ATOMIC_RELAXED, __HIP_MEMORY_SCOPE_AGENT);
        }
        while (__hip_atomic_load(cnt, __ATOMIC_RELAXED, __HIP_MEMORY_SCOPE_AGENT) < ngrp) __builtin_amdgcn_s_sleep(1);
        __builtin_amdgcn_fence(__ATOMIC_ACQUIRE, "agent");
    }
    __syncthreads();
}
__global__ void __launch_bounds__(512, 2) mega(Params p_unused) {
    extern __shared__ __attribute__((aligned(16))) unsigned char lds[];
    KP p = (KP)__builtin_amdgcn_kernarg_segment_ptr();
#define FRESH() asm volatile("" : "+s"(p))
    cg::grid_group grid = cg::this_grid();
    PG8_LAS unsigned char* lds3 = (PG8_LAS unsigned char*)lds;
    const int mk_wid = __builtin_amdgcn_readfirstlane((int)(threadIdx.x >> 6));
    const int G = (int)gridDim.x, bid = (int)blockIdx.x; const int ph_lo = p->ph_lo, ph_hi = p->ph_hi;
#define IN(k) (ph_lo <= (k) && (k) < ph_hi)
#define SEAM(k) do { if ((k) + 1 < ph_hi) { if ((k) == 0) grid.sync(); else gbar((unsigned*)(p->ws + WS_BAR) + 512 * ((k) + 16 * rep_), (unsigned)G, mk_wid); } FRESH(); } while (0)
#ifndef MK_DUP
#define MK_DUP (-1)
#endif
#define REPS(k) for (int rep_ = 0; rep_ < ((MK_DUP) == (k) ? 2 : 1); ++rep_)
    if (IN(0)) REPS(0) { phase0(p, lds, mk_wid); SEAM(0); }
    if (IN(1)) REPS(1) {
        pg8::Gemm g{(const pg8::bf16_t*)(p->ws + WS_XN), (const pg8::bf16_t*)(p->ws + WS_WIN), MROWS, NZ, DMODEL, DMODEL}; pg8::StaticOrder S; S.init(MROWS, NZ, G, bid);
        EpiIn E{p->out, p->ws, p->in[8], p->in[10], p->in[11]};
        pg8::gemm_phase<EpiIn, pg8::StaticOrder, true, true>(lds3, g, S, E, mk_wid);
        SEAM(1);
    }
    if (IN(2)) REPS(2) {
        for (int u = bid; u < 20 + 272 + 1056; u += G) { if (u < 20) cumsum_unit(p, u, lds, mk_wid); else if (u < 292) norm_unit(p, u - 20, mk_wid); else g1_unit(p, u - 292, lds, mk_wid); }
        SEAM(2);
    }
    if (IN(3)) REPS(3) { phase3(p, lds, mk_wid); SEAM(3); }
    if (IN(4)) REPS(4) {
        { pg8::Gemm g{(const pg8::bf16_t*)(p->ws + WS_QP), (const pg8::bf16_t*)(p->ws + WS_WPA), MROWS, DMODEL, 512, 512}; pg8::StaticOrder S; S.init(MROWS, DMODEL, G, bid);
          EpiBf<0> E{p->out, p->ws}; pg8::gemm_phase<EpiBf<0>, pg8::StaticOrder, true, true>(lds3, g, S, E, mk_wid); }
        __syncthreads();
        phase4(p, lds, mk_wid, G > 64 ? 4 : 0); SEAM(4); }
    if (IN(5)) REPS(5) {
        { pg8::Gemm g{(const pg8::bf16_t*)(p->ws + WS_OG), (const pg8::bf16_t*)(p->ws + WS_WPB), MROWS, DMODEL, 512, 512}; pg8::StaticOrder S; S.init(MROWS, DMODEL, G, bid);
          EpiBf<1> E{p->out, p->ws}; pg8::gemm_phase<EpiBf<1>, pg8::StaticOrder, true, true>(lds3, g, S, E, mk_wid); }
        SEAM(5);
    }
    if (IN(6)) REPS(6) {
        { pg8::Gemm g{(const pg8::bf16_t*)(p->ws + WS_MB), (const pg8::bf16_t*)(p->ws + WS_WOUT), NPROMPT, DMODEL, DMODEL, DMODEL}; pg8::StaticOrder S; S.init(NPROMPT, DMODEL, G, bid);
          EpiF32SS E{(float*)(p->ws + WS_MIX), (float*)(p->ws + WS_RS1)};
          pg8::gemm_phase<EpiF32SS, pg8::StaticOrder, true, true>(lds3, g, S, E, mk_wid); }
        __syncthreads();
        { const int ks = (bid >> 2) & 3;
          pg8::Gemm g{(const pg8::bf16_t*)(p->ws + WS_MB) + ks * 256, (const pg8::bf16_t*)(p->ws + WS_WOUT) + ks * 256, MROWS, DMODEL, 256, DMODEL}; SplitOrder S{bid};
          EpiPart E{(float*)(p->ws + WS_DOWNP) + (size_t)ks * 262144};
          pg8::gemm_phase<EpiPart, SplitOrder, true, true>(lds3, g, S, E, mk_wid); }
        SEAM(6);
    }
    if (IN(7)) REPS(7) { phase7(p, mk_wid); SEAM(7); }
    if (IN(8)) REPS(8) {
        pg8::Gemm g{(const pg8::bf16_t*)(p->ws + WS_XN2), (const pg8::bf16_t*)(p->ws + WS_WUP), MROWS, DFF, DMODEL, DMODEL}; pg8::StaticOrder S; S.init(MROWS, DFF, G, bid);
        EpiBf<2> E{p->out, p->ws}; pg8::gemm_phase<EpiBf<2>, pg8::StaticOrder, true, true>(lds3, g, S, E, mk_wid);
        SEAM(8);
    }
    if (IN(9)) REPS(9) {
        { pg8::Gemm g{(const pg8::bf16_t*)(p->ws + WS_H), (const pg8::bf16_t*)(p->ws + WS_WDN), NPROMPT, DMODEL, DFF, DFF}; pg8::StaticOrder S; S.init(NPROMPT, DMODEL, G, bid);
          EpiF32SS E{(float*)(p->ws + WS_DOWN), (float*)(p->ws + WS_RS2)};
          pg8::gemm_phase<EpiF32SS, pg8::StaticOrder, true, true>(lds3, g, S, E, mk_wid); }
        __syncthreads();
        { const int ks = (bid >> 2) & 3;
          pg8::Gemm g{(const pg8::bf16_t*)(p->ws + WS_H) + ks * 1024, (const pg8::bf16_t*)(p->ws + WS_WDN) + ks * 1024, MROWS, DMODEL, 1024, DFF}; SplitOrder S{bid};
          EpiPart E{(float*)(p->ws + WS_DOWNP) + (size_t)ks * 262144};
          pg8::gemm_phase<EpiPart, SplitOrder, true, true>(lds3, g, S, E, mk_wid); }
        SEAM(9);
    }
    if (IN(10)) REPS(10) { phase10(p, mk_wid); }
#if defined(MK_DUMP_OFF)
#ifndef MK_AMP
#define MK_AMP(v) (v)
#endif
    if (IN(99)) { const bf16_t* src = (const bf16_t*)(p->ws + (size_t)(MK_DUMP_OFF)); const int tid = mk_tid(mk_wid);
        for (size_t e = (size_t)bid * 512 + tid; e < (size_t)MROWS * 1024; e += (size_t)G * 512) { const size_t row = e >> 10; const int c = (int)(e & 1023);
#if defined(MK_DUMP_F32)
            p->out[O_Y + e] = MK_AMP(((const float*)src)[e]); } }
#else
            p->out[O_Y + e] = c < (MK_DUMP_W) ? MK_AMP(bf2f(src[row * (MK_DUMP_W) + c])) : 0.f; } }
#endif
#endif
#undef IN
#undef SEAM
}
}

extern "C" void kernel_launch(void* const* d_in, const int* in_sizes, int n_in, void* d_out, int out_size, void* d_ws, size_t ws_size, hipStream_t stream) {
    using namespace mk;
    static int grid = 0;
    if (grid == 0) {
        if (n_in != 22 || (size_t)out_size != O_END || ws_size < WS_END) { fprintf(stderr, "kernel_launch: unexpected shapes: n_in %d out %d ws %zu (need %zu)\n", n_in, out_size, ws_size, (size_t)WS_END); grid = -1; return; }
        int dev = 0, cus = 0, per_cu = 0;
        if (hipGetDevice(&dev) != hipSuccess || hipDeviceGetAttribute(&cus, hipDeviceAttributeMultiprocessorCount, dev) != hipSuccess) { grid = -1; return; }
        if (hipFuncSetAttribute((const void*)mega, hipFuncAttributeMaxDynamicSharedMemorySize, LDS_BYTES) != hipSuccess) { fprintf(stderr, "kernel_launch: hipFuncSetAttribute failed\n"); grid = -1; return; }
        if (hipOccupancyMaxActiveBlocksPerMultiprocessor(&per_cu, (const void*)mega, 512, LDS_BYTES) != hipSuccess || per_cu < 1) { fprintf(stderr, "kernel_launch: occupancy query failed (%d)\n", per_cu); (void)hipGetLastError(); per_cu = 1; }
        grid = cus * 1;
    }
    if (grid < 0) return;
    (void)hipMemsetAsync((unsigned char*)d_ws + WS_BAR, 0, 65536, stream);
    Params p{};
    for (int i = 0; i < 22; ++i) p.in[i] = (const float*)d_in[i];
    p.out = (float*)d_out; p.ws = (unsigned char*)d_ws;
#if MK_PER_PHASE
    for (int ph = 0; ph < MK_PH_MAX; ++ph) { p.ph_lo = ph; p.ph_hi = ph + 1; hipLaunchKernelGGL(mega, dim3(grid), dim3(512), LDS_BYTES, stream, p); }
#if defined(MK_DUMP_OFF)
    p.ph_lo = 99; p.ph_hi = 100; hipLaunchKernelGGL(mega, dim3(grid), dim3(512), LDS_BYTES, stream, p);
#endif
#else
    p.ph_lo = 0; p.ph_hi = 11;
    void* args[] = {&p};
    hipError_t e = hipLaunchCooperativeKernel((const void*)mega, dim3(grid), dim3(512), args, LDS_BYTES, stream);
    if (e != hipSuccess) fprintf(stderr, "kernel_launch: cooperative launch failed: %s (grid %d)\n", hipGetErrorString(e), grid);
#endif
}
```

```cpp
#include <hip/hip_runtime.h>
#include <hip/hip_cooperative_groups.h>
#include <hip/hip_bf16.h>
#include <cstdio>
#include <cstdint>
#include <cmath>
namespace cg = cooperative_groups;
#ifndef MK_PH_MAX
#define MK_PH_MAX 11
#endif
#ifndef MK_PER_PHASE
#define MK_PER_PHASE 0
#endif
__device__ __forceinline__ int mk_tid(int wid_s) { return wid_s * 64 + (int)__builtin_amdgcn_mbcnt_hi(~0u, __builtin_amdgcn_mbcnt_lo(~0u, 0u)); }
namespace pg8 {
#define PG8_LAS __attribute__((address_space(3)))
typedef unsigned short bf16_t;
typedef short bf16x8 __attribute__((ext_vector_type(8)));
typedef float f32x4 __attribute__((ext_vector_type(4)));
typedef unsigned u32x4 __attribute__((ext_vector_type(4)));
constexpr int BM = 256, BK = 64, HALF = 128, HTB = HALF * BK * 2  , STAGE_BYTES = 8 * HTB, NXCD = 8, WGM = 8;

__host__ __device__ __forceinline__ int lds_byte(int r, int c) { const int st = (r >> 4) * 2 + (c >> 5), rr = r & 15, cc = c & 31, ob = rr * 64 + cc * 2; return st * 1024 + (ob ^ (((ob >> 9) & 1) << 5)); }
__host__ __device__ __forceinline__ void stage_rc(int b, int& R, int& C) { const int st = b / 1024, sb = b % 1024, swz = sb ^ (((sb >> 9) & 1) << 5); R = (st >> 1) * 16 + swz / 64; C = (st & 1) * 32 + (swz % 64) / 2; }
__host__ __device__ __forceinline__ int perm32(int rho) { const int n = rho >> 4, i = rho & 15; return 8 * (i >> 2) + 4 * n + (i & 3); }

struct Unit { int pm, pn; };
struct Gemm { const bf16_t* A; const bf16_t* Bt; int M, N, K, ld; };

struct StaticOrder {
    int nM, nN, nwg, G, c;
    __host__ __device__ void init(int M, int N, int G_, int c_) { nM = M / BM; nN = N / BM; nwg = nM * nN; G = G_; c = c_; }
    __host__ __device__ bool next(int i, Unit& u) const {
        const long L = (long)i * G + c; if (L >= nwg) return false;
        int wgid = (int)L; { const int q = nwg / NXCD, r = nwg % NXCD, xcd = wgid % NXCD, off = wgid / NXCD; wgid = (xcd < r ? xcd * (q + 1) : r * (q + 1) + (xcd - r) * q) + off; }
        const int nig = WGM * nN, gid = wgid / nig, fm = gid * WGM, gsz = (nM - fm) < WGM ? (nM - fm) : WGM;
        u.pm = fm + ((wgid % nig) % gsz); u.pn = (wgid % nig) / gsz; return true;
    }
    __device__ __forceinline__ void a_ready(const Unit&) const {}
    __device__ __forceinline__ void done(const Unit&) const {}
};

__device__ __forceinline__ unsigned cvt_pk_bf16(float lo, float hi) { unsigned r; asm volatile("v_cvt_pk_bf16_f32 %0, %1, %2" : "=v"(r) : "v"(lo), "v"(hi)); return r; }
template <class Epi, class Sched, bool ALIGN_EPI = false, bool SP2 = false>
__device__ __forceinline__ void gemm_phase(PG8_LAS unsigned char* lds, const Gemm g, const Sched& S, const Epi& E, const int mk_wid) {
    const int wid = mk_wid, tid = mk_tid(mk_wid), lane = tid & 63, wr = wid >> 2, wc = wid & 3, fr = lane & 15, fq = lane >> 4;
    const int K = g.K, LD = g.ld, nt = K / BK;
    unsigned voffA[2], voffB[2];
#pragma unroll
    for (int i = 0; i < 2; ++i) { int R, C; stage_rc(tid * 16 + i * 8192, R, C); const int Rb = Epi::PERM ? ((R & ~31) + perm32(R & 31)) : R;
        voffA[i] = (unsigned)(R * LD + C) * 2u; voffB[i] = (unsigned)(Rb * LD + C) * 2u; }
    const size_t kstep = (size_t)(BK * 2);
    const size_t hstep = (size_t)HALF * LD * 2;
    const size_t tstep = 2 * hstep;
    const unsigned ldsw = (unsigned)wid * 1024u;
    const int aoff = lds_byte(wr * 64 + fr, fq * 8), boff = lds_byte(wc * 32 + fr, fq * 8);
#define PG8_SA(b, h) (((b) * 2 + (h)) * HTB)
#define PG8_SB(b, h) ((4 + (b) * 2 + (h)) * HTB)
#define PG8_STAGE(bufoff, gbase, voff) do { _Pragma("unroll") for (int _i = 0; _i < 2; ++_i) \
        __builtin_amdgcn_global_load_lds((const unsigned*)((const char*)(gbase) + (voff)[_i]), (PG8_LAS unsigned*)(lds + (bufoff) + ldsw + _i * 8192), 16, 0, 0); } while (0)
#define PG8_LDA(dst, b, h) do { _Pragma("unroll") for (int m = 0; m < 4; ++m) _Pragma("unroll") for (int k = 0; k < 2; ++k) dst[m][k] = *(const PG8_LAS bf16x8*)(lds + PG8_SA(b, h) + aoff + m * 2048 + k * 1024); } while (0)
#define PG8_LDB(dst, b, h) do { _Pragma("unroll") for (int n = 0; n < 2; ++n) _Pragma("unroll") for (int k = 0; k < 2; ++k) dst[n][k] = *(const PG8_LAS bf16x8*)(lds + PG8_SB(b, h) + boff + n * 2048 + k * 1024); } while (0)
#define PG8_MMA(ai, bj, At, Bt) do { __builtin_amdgcn_s_setprio(1); _Pragma("unroll") for (int m = 0; m < 4; ++m) _Pragma("unroll") for (int n = 0; n < 2; ++n) _Pragma("unroll") for (int k = 0; k < 2; ++k) \
        acc[ai][bj][m][n] = __builtin_amdgcn_mfma_f32_16x16x32_bf16(Bt[n][k], At[m][k], acc[ai][bj][m][n], 0, 0, 0); __builtin_amdgcn_s_setprio(0); } while (0)
#define PG8_WAIT_V(n) asm volatile("s_waitcnt vmcnt(" #n ")" ::: "memory")
#define PG8_WAIT_L(n) asm volatile("s_waitcnt lgkmcnt(" #n ")" ::: "memory")
#define PG8_BAR __builtin_amdgcn_s_barrier()
#define PG8_SCHED __builtin_amdgcn_sched_barrier(0)
    Unit cur, nxt; int ui = 0;
    if (!S.next(0, cur)) return;
    f32x4 acc[2][2][4][2];
#pragma unroll
    for (int a = 0; a < 2; ++a)
#pragma unroll
        for (int b = 0; b < 2; ++b)
#pragma unroll
            for (int m = 0; m < 4; ++m)
#pragma unroll
                for (int n = 0; n < 2; ++n) acc[a][b][m][n] = (f32x4){0.f, 0.f, 0.f, 0.f};
    bf16x8 At[4][2], B0[2][2], B1[2][2];
    const char* cA = (const char*)g.A + (size_t)cur.pm * tstep; const char* cB = (const char*)g.Bt + (size_t)cur.pn * tstep;
    S.a_ready(cur);
    if constexpr (SP2) {
        PG8_STAGE(PG8_SB(0, 0), cB, voffB); PG8_STAGE(PG8_SB(0, 1), cB + hstep, voffB); PG8_STAGE(PG8_SA(0, 0), cA, voffA); PG8_STAGE(PG8_SA(0, 1), cA + hstep, voffA);
        if (wr == 1) PG8_BAR;
        PG8_WAIT_V(2); PG8_BAR;
        PG8_STAGE(PG8_SB(1, 0), cB + kstep, voffB); PG8_STAGE(PG8_SA(1, 0), cA + kstep, voffA); PG8_STAGE(PG8_SB(1, 1), cB + hstep + kstep, voffB);
        PG8_WAIT_V(6); PG8_BAR;
    } else {
        PG8_STAGE(PG8_SB(0, 0), cB, voffB); PG8_STAGE(PG8_SA(0, 0), cA, voffA); PG8_STAGE(PG8_SB(0, 1), cB + hstep, voffB); PG8_STAGE(PG8_SA(0, 1), cA + hstep, voffA);
        if (wr == 1) PG8_BAR;
        PG8_WAIT_V(4); PG8_BAR;
        PG8_STAGE(PG8_SB(1, 0), cB + kstep, voffB); PG8_STAGE(PG8_SA(1, 0), cA + kstep, voffA); PG8_STAGE(PG8_SB(1, 1), cB + hstep + kstep, voffB);
        PG8_WAIT_V(6); PG8_BAR;
    }
    for (;;) {
        const bool has_next = S.next(ui + 1, nxt);
        const char* nA = has_next ? (const char*)g.A + (size_t)nxt.pm * tstep : cA; const char* nB = has_next ? (const char*)g.Bt + (size_t)nxt.pn * tstep : cB;
        for (int t = 0; t < nt; t += 2) {
            const bool last = (t == nt - 2);
            const char* a1 = cA + (size_t)(t + 1) * kstep;
            const char* a2 = last ? nA : cA + (size_t)(t + 2) * kstep; const char* b2 = last ? nB : cB + (size_t)(t + 2) * kstep;
            const char* a3 = a2 + kstep; const char* b3 = b2 + kstep;
            if (last && has_next) S.a_ready(nxt);
            if constexpr (SP2) {
            PG8_LDB(B0, 0, 0); PG8_LDB(B1, 0, 1); PG8_SCHED; PG8_LDA(At, 0, 0); PG8_STAGE(PG8_SA(1, 1), a1 + hstep, voffA);
            PG8_WAIT_V(8); PG8_WAIT_L(0); PG8_BAR; PG8_MMA(0, 0, At, B0); PG8_MMA(0, 1, At, B1); PG8_BAR; PG8_SCHED;
            PG8_LDA(At, 0, 1); PG8_STAGE(PG8_SB(0, 0), b2, voffB); PG8_STAGE(PG8_SB(0, 1), b2 + hstep, voffB); PG8_STAGE(PG8_SA(0, 0), a2, voffA);
            PG8_WAIT_V(8); PG8_WAIT_L(0); PG8_BAR; PG8_MMA(1, 0, At, B0); PG8_MMA(1, 1, At, B1); PG8_BAR; PG8_SCHED;
            PG8_LDB(B0, 1, 0); PG8_LDB(B1, 1, 1); PG8_SCHED; PG8_LDA(At, 1, 0); PG8_STAGE(PG8_SA(0, 1), a2 + hstep, voffA);
            PG8_WAIT_V(8); PG8_WAIT_L(0); PG8_BAR; PG8_MMA(0, 0, At, B0); PG8_MMA(0, 1, At, B1); PG8_BAR; PG8_SCHED;
            PG8_LDA(At, 1, 1); PG8_STAGE(PG8_SB(1, 0), b3, voffB); PG8_STAGE(PG8_SB(1, 1), b3 + hstep, voffB); PG8_STAGE(PG8_SA(1, 0), a3, voffA);
            PG8_WAIT_V(8); PG8_WAIT_L(0); PG8_BAR; PG8_MMA(1, 0, At, B0); PG8_MMA(1, 1, At, B1); PG8_BAR; PG8_SCHED;
            } else {
            PG8_LDB(B0, 0, 0); PG8_SCHED; PG8_LDA(At, 0, 0); PG8_STAGE(PG8_SA(1, 1), a1 + hstep, voffA);
            PG8_WAIT_L(8); PG8_BAR; PG8_WAIT_L(0); PG8_MMA(0, 0, At, B0); PG8_BAR; PG8_SCHED;
            PG8_LDB(B1, 0, 1); PG8_STAGE(PG8_SB(0, 0), b2, voffB);
            PG8_BAR; PG8_WAIT_L(0); PG8_MMA(0, 1, At, B1); PG8_BAR;
            PG8_LDA(At, 0, 1); PG8_STAGE(PG8_SA(0, 0), a2, voffA);
            PG8_BAR; PG8_WAIT_L(0); PG8_MMA(1, 0, At, B0); PG8_BAR; PG8_SCHED;
            PG8_STAGE(PG8_SB(0, 1), b2 + hstep, voffB);
            PG8_WAIT_V(6); PG8_BAR; PG8_MMA(1, 1, At, B1); PG8_BAR;
            PG8_LDB(B0, 1, 0); PG8_SCHED; PG8_LDA(At, 1, 0); PG8_STAGE(PG8_SA(0, 1), a2 + hstep, voffA);
            PG8_WAIT_L(8); PG8_BAR; PG8_WAIT_L(0); PG8_MMA(0, 0, At, B0); PG8_BAR; PG8_SCHED;
            PG8_LDB(B1, 1, 1); PG8_STAGE(PG8_SB(1, 0), b3, voffB);
            PG8_BAR; PG8_WAIT_L(0); PG8_MMA(0, 1, At, B1); PG8_BAR;
            PG8_LDA(At, 1, 1); PG8_STAGE(PG8_SA(1, 0), a3, voffA);
            PG8_BAR; PG8_WAIT_L(0); PG8_MMA(1, 0, At, B0); PG8_BAR; PG8_SCHED;
            PG8_STAGE(PG8_SB(1, 1), b3 + hstep, voffB);
            PG8_WAIT_V(6); PG8_BAR; PG8_MMA(1, 1, At, B1); PG8_BAR;
            }
        }
        if constexpr (ALIGN_EPI) { if (wr == 0) PG8_BAR; }
        if constexpr (!Epi::AFTER_DRAIN) { E(acc, cur, wr, wc, fr, fq); S.done(cur); }
        if (!has_next) break;
#pragma unroll
        for (int a = 0; a < 2; ++a)
#pragma unroll
            for (int b = 0; b < 2; ++b)
#pragma unroll
                for (int m = 0; m < 4; ++m)
#pragma unroll
                    for (int n = 0; n < 2; ++n) acc[a][b][m][n] = (f32x4){0.f, 0.f, 0.f, 0.f};
        cur = nxt; cA = nA; cB = nB; ++ui;
        if constexpr (ALIGN_EPI) { if (wr == 1) PG8_BAR; }
    }
    PG8_WAIT_V(0);
    if constexpr (!ALIGN_EPI) { if (wr == 0) PG8_BAR; }
    PG8_BAR;
    if constexpr (Epi::AFTER_DRAIN) { E.fused(acc, cur, wr, wc, fr, fq, lds, wid, lane); S.done(cur); }
#undef PG8_SA
#undef PG8_SB
#undef PG8_STAGE
#undef PG8_LDA
#undef PG8_LDB
#undef PG8_MMA
#undef PG8_WAIT_V
#undef PG8_WAIT_L
#undef PG8_BAR
#undef PG8_SCHED
}
}
namespace attn_body {
using bf16=__hip_bfloat16;
using bf16x8=__attribute__((ext_vector_type(8)))short;
using s16x4=__attribute__((ext_vector_type(4)))short;
using f32x16=__attribute__((ext_vector_type(16)))float;
using u32x4=__attribute__((ext_vector_type(4)))unsigned;
constexpr int NHEAD=8,D=64,DM=NHEAD*D;
constexpr int NW=8,QBLK=32,QB=QBLK*NW,KVBLK=64;
constexpr int ATTN_PITCH=DM, ATTN_UNIT_ROWS=QB;
__device__ __forceinline__ int crow(int r,int hi){return (r&3)+8*(r>>2)+4*hi;}
#define SBAR() __builtin_amdgcn_sched_barrier(0)
__device__ __forceinline__ void cmask(f32x16&p0,f32x16&p1,int jb,int qrel,int hi){
  const float NEG=-INFINITY; int kb=64*jb+4*hi;
  #pragma unroll
  for(int r=0;r<16;++r){int kv=kb+(r&3)+8*(r>>2); if(kv>qrel)p0[r]=NEG; if(kv+32>qrel)p1[r]=NEG;}
}

constexpr int NSLOT=3, SLOTB=8192;
constexpr int LDS_K=0, LDS_V=NSLOT*SLOTB, LDS_WS=2*NSLOT*SLOTB, LDS_OST=LDS_WS+NW*64*4, LDS_BYTES=LDS_OST+NW*4096;
constexpr float C2=0.125f*1.4426950408889634f;
__device__ __forceinline__ void glds16(const void*gsrc,unsigned lds_dst){unsigned keep;
  asm volatile("s_mov_b32 %0, m0\n\ts_mov_b32 m0, %2\n\ts_nop 0\n\tglobal_load_lds_dwordx4 %1, off\n\ts_mov_b32 m0, %0":"=&s"(keep):"v"(gsrc),"s"(lds_dst):"memory");}
__device__ __forceinline__ void glds16s(const void*sbase,unsigned voff,unsigned lds_dst){unsigned keep;
  asm volatile("s_mov_b32 %0, m0\n\ts_mov_b32 m0, %3\n\ts_nop 0\n\tglobal_load_lds_dwordx4 %1, %2\n\ts_mov_b32 m0, %0":"=&s"(keep):"v"(voff),"s"(sbase),"s"(lds_dst):"memory");}
__device__ __forceinline__ float max3f(float a,float b,float c){float r;asm("v_max3_f32 %0, %1, %2, %3":"=v"(r):"v"(a),"v"(b),"v"(c));return r;}
__device__ __forceinline__ float max2f(float a,float b){float r;asm("v_max_f32_e32 %0, %1, %2":"=v"(r):"v"(a),"v"(b));return r;}
__device__ __forceinline__ float fadd_s(float a,float b){float r;asm("v_add_f32_e32 %0, %1, %2":"=v"(r):"v"(a),"v"(b));return r;}
__device__ __forceinline__ float fsub_s(float a,float b){float r;asm("v_sub_f32_e32 %0, %1, %2":"=v"(r):"v"(a),"v"(b));return r;}
typedef float f32x2_t __attribute__((ext_vector_type(2))); typedef __bf16 bf16x2_t __attribute__((ext_vector_type(2)));
__device__ __forceinline__ unsigned cvtpk_s(float lo,float hi){f32x2_t v={lo,hi};bf16x2_t b=__builtin_convertvector(v,bf16x2_t);return __builtin_bit_cast(unsigned,b);}
#define WAIT_BAR(N) asm volatile("s_waitcnt vmcnt(" #N ") lgkmcnt(0)\n\ts_barrier":::"memory")

__device__ __forceinline__ void qkt(f32x16&p0,f32x16&p1,const char*Kslot,const bf16x8*qr,const f32x16&i0,const f32x16&i1,int r32,int hi){
  const char*kb=Kslot+hi*1024+r32*16;
  #pragma unroll
  for(int d0=0;d0<4;++d0){
    const bf16x8 b0=*reinterpret_cast<const bf16x8*>(kb+d0*2048);
    const bf16x8 b1=*reinterpret_cast<const bf16x8*>(kb+d0*2048+512);
    if(d0==0){p0=__builtin_amdgcn_mfma_f32_32x32x16_bf16(b0,qr[0],i0,0,0,0);p1=__builtin_amdgcn_mfma_f32_32x32x16_bf16(b1,qr[0],i1,0,0,0);}
    else{p0=__builtin_amdgcn_mfma_f32_32x32x16_bf16(b0,qr[d0],p0,0,0,0);p1=__builtin_amdgcn_mfma_f32_32x32x16_bf16(b1,qr[d0],p1,0,0,0);}}
}
typedef __attribute__((address_space(3))) const char* lds_cptr;
typedef short v4i16_t __attribute__((ext_vector_type(4)));
__device__ __forceinline__ void kload8(bf16x8*kf,lds_cptr kp){
  kf[0]=*(const __attribute__((address_space(3))) bf16x8*)(kp);      kf[1]=*(const __attribute__((address_space(3))) bf16x8*)(kp+512);
  kf[2]=*(const __attribute__((address_space(3))) bf16x8*)(kp+2048); kf[3]=*(const __attribute__((address_space(3))) bf16x8*)(kp+2560);
  kf[4]=*(const __attribute__((address_space(3))) bf16x8*)(kp+4096); kf[5]=*(const __attribute__((address_space(3))) bf16x8*)(kp+4608);
  kf[6]=*(const __attribute__((address_space(3))) bf16x8*)(kp+6144); kf[7]=*(const __attribute__((address_space(3))) bf16x8*)(kp+6656);
}
__device__ __forceinline__ void kload2(bf16x8*kf,lds_cptr kp,int j){ kf[2*j]=*(const __attribute__((address_space(3))) bf16x8*)(kp+j*2048); kf[2*j+1]=*(const __attribute__((address_space(3))) bf16x8*)(kp+j*2048+512); }
__device__ __forceinline__ s16x4 vtr(lds_cptr p){ return __builtin_bit_cast(s16x4,__builtin_amdgcn_ds_read_tr16_b64_v4i16((__attribute__((address_space(3))) v4i16_t*)p)); }
__device__ __forceinline__ float rowmax(const f32x16&p0,const f32x16&p1){
  float a=max3f(p0[0],p0[1],p1[0]),b=max3f(p0[2],p0[3],p1[1]);a=max3f(a,p1[2],p1[3]);
  #pragma unroll
  for(int r=4;r<16;r+=4){a=max3f(a,p0[r],p0[r+1]);b=max3f(b,p0[r+2],p0[r+3]);a=max3f(a,p1[r],p1[r+1]);b=max3f(b,p1[r+2],p1[r+3]);}
  const float m=max2f(a,b);
  auto rr=__builtin_amdgcn_permlane32_swap(__float_as_uint(m),__float_as_uint(m),false,false);
  return max2f(__uint_as_float(rr[0]),__uint_as_float(rr[1]));
}
__device__ __forceinline__ void pv(f32x16*o,int vb,bf16x8 pa0,bf16x8 pa1,bf16x8 pa2,bf16x8 pa3){
  #pragma unroll
  for(int d0=0;d0<2;++d0){s16x4 lo[4],hi[4];
    #pragma unroll
    for(int ks=0;ks<4;++ks){
      asm volatile("ds_read_b64_tr_b16 %0,%1 offset:%c2":"=&v"(lo[ks]):"v"(vb),"i"(d0*4096+ks*1024):"memory");
      asm volatile("ds_read_b64_tr_b16 %0,%1 offset:%c2":"=&v"(hi[ks]):"v"(vb),"i"(d0*4096+ks*1024+512):"memory");}
    asm volatile("s_waitcnt lgkmcnt(0)":::"memory");SBAR();
    #define PK(k) (bf16x8){lo[k][0],lo[k][1],lo[k][2],lo[k][3],hi[k][0],hi[k][1],hi[k][2],hi[k][3]}
    o[d0]=__builtin_amdgcn_mfma_f32_32x32x16_bf16(pa0,PK(0),o[d0],0,0,0);
    o[d0]=__builtin_amdgcn_mfma_f32_32x32x16_bf16(pa1,PK(1),o[d0],0,0,0);
    o[d0]=__builtin_amdgcn_mfma_f32_32x32x16_bf16(pa2,PK(2),o[d0],0,0,0);
    o[d0]=__builtin_amdgcn_mfma_f32_32x32x16_bf16(pa3,PK(3),o[d0],0,0,0);
    #undef PK
  }
}

#ifndef ATTN_STORE16
#define ATTN_STORE16(p,v) (*(u32x4*)(p)=(v))
#endif
template<int THRL> __device__ __forceinline__ void attn_unit(int q0,int nvalid,const bf16*Qu,const bf16*__restrict__ Kh,const bf16*__restrict__ Vh,bf16*Ou,const float*__restrict__ G,char*shm,const int mk_wid){
  const int wid=mk_wid,tid=mk_tid(mk_wid),lane=tid&63,r32=lane&31,hi=lane>>5;
  const bf16*Qw=Qu+(long)(wid*QBLK)*DM;
  const unsigned lds0=(unsigned)(uintptr_t)shm;
  float*wsf=(float*)(shm+LDS_WS)+wid*64;
  const unsigned kvoff=(unsigned)((lane*DM+wid*8)*2);
  const unsigned vvoff=(unsigned)(((16*(wid&3)+(lane>>2))*DM+(wid>>2)*32+(lane&3)*8)*2);
  const unsigned kdst=lds0+LDS_K+wid*1024, vdst=lds0+LDS_V+wid*1024;
  #define DMA_K(t,slot) glds16s(Kh+(long)(t)*KVBLK*DM,kvoff,(unsigned)__builtin_amdgcn_readfirstlane(kdst+(slot)))
  #define DMA_V(t,slot) glds16s(Vh+(long)(t)*KVBLK*DM,vvoff,(unsigned)__builtin_amdgcn_readfirstlane(vdst+(slot)))
  const int vb0=(int)(lds0+LDS_V)+((lane>>4)&1)*32+(lane&3)*8+(4*hi+((lane&15)>>2))*64;
  const char*Kbase=shm+LDS_K; bf16x8 kf[8];
  const lds_cptr shm3=(lds_cptr)shm; const lds_cptr kp0=shm3+LDS_K+hi*1024+r32*16; const lds_cptr vp0=shm3+LDS_V+((lane>>4)&1)*32+(lane&3)*8+(4*hi+((lane&15)>>2))*64;
  { float*fbw=(float*)(shm+LDS_OST); const float gref=G[q0]; for(int j=tid;j<q0+QB;j+=512) fbw[j]=(gref-G[j])*1.4426950408889634f; }
  const __attribute__((address_space(3))) float* fbl=(const __attribute__((address_space(3))) float*)(shm3+LDS_OST)+r32;
  #define BIASMF(t,w,bq) __builtin_amdgcn_mfma_f32_32x32x2f32((hi?1.0f:fbl[64*(t)+32*(w)]),(bq),negm,0,0,0)
  const int NT=(q0+QB)/KVBLK;
  DMA_K(0,0);DMA_V(0,0);DMA_K(1,SLOTB);
  bf16x8 qr[4];
  #pragma unroll
  for(int d0=0;d0<4;++d0)qr[d0]=*reinterpret_cast<const bf16x8*>(&Qw[(long)r32*DM+d0*16+hi*8]);
  float mhat=0.f,l_reg=0.f;f32x16 o[2];o[0]=f32x16{};o[1]=f32x16{};const f32x16 negm=f32x16{};
  const int qrel=wid*QBLK+r32;
  #define CMASK(P0,P1,t) do{int jb_=(t)-(NT-4); if(jb_>=0)cmask(P0,P1,jb_,qrel,hi);}while(0)
  bool resc=false;
  #define START(P0,P1) do{ const float rm=rowmax(P0,P1); resc=false; \
    { const float dl=rm; mhat=fadd_s(mhat,dl); \
      _Pragma("unroll") for(int r=0;r<16;++r){P0[r]=fsub_s(P0[r],dl);P1[r]=fsub_s(P1[r],dl);} \
      } \
    _Pragma("unroll") for(int r=0;r<16;++r)P0[r]=__builtin_amdgcn_exp2f(P0[r]); }while(0)
  #define RESC() do{ if(resc){ asm volatile("s_waitcnt lgkmcnt(0)":::"memory"); \
      _Pragma("unroll") for(int d_=0;d_<2;++d_) _Pragma("unroll") for(int r=0;r<16;++r)o[d_][r]*=wsf[crow(r,hi)]; } }while(0)
  f32x16 pA0,pA1,pB0,pB1;
  int sl_prev=0,sl_cur=0,sl_next=SLOTB;
  #define ROT() do{sl_prev=sl_cur;sl_cur=sl_next;sl_next=(sl_next==(NSLOT-1)*SLOTB)?0:sl_next+SLOTB;}while(0)
  DMA_K(2,2*SLOTB);
  WAIT_BAR(3);
  { const float bq0_=hi?0.f:1.f; qkt(pA0,pA1,Kbase,qr,BIASMF(0,0,bq0_),BIASMF(0,1,bq0_),r32,hi); }asm volatile("s_nop 15\n\ts_nop 7":"+v"(pA0),"+v"(pA1));CMASK(pA0,pA1,0);
  START(pA0,pA1);
  _Pragma("unroll") for(int r=0;r<16;++r)pA1[r]=__builtin_amdgcn_exp2f(pA1[r]);
  WAIT_BAR(0);
  DMA_K(3,0);DMA_V(1,SLOTB);
  ROT();
  kload8(kf,kp0+sl_cur);
  WAIT_BAR(2);
  s16x4 vlo[8],vhi[8]; u32x4 pw0,pw1,pw2,pw3;
  #define PKW(P,B) cvtpk_s(P[B],P[B+1])
  #define PAF(k) __builtin_bit_cast(bf16x8,pw##k)
  #define VFR(i) (bf16x8){vlo[i][0],vlo[i][1],vlo[i][2],vlo[i][3],vhi[i][0],vhi[i][1],vhi[i][2],vhi[i][3]}
  #define PIN(x) asm volatile("":"+v"(x))
  #define MX3(a,b,c) __builtin_fmaxf(__builtin_fmaxf((a),(b)),(c))
  #define GAPA(MF,A0,A1,A2,A3,W0,W1,PW) do{ MF; sacc+=A0; sacc+=A1; sacc+=A2; sacc+=A3; PIN(sacc); W0; W1; PIN(PW); SBAR(); }while(0)
  #define EX(v) __builtin_amdgcn_exp2f(v)
  #define GAPB(MF,X,B) do{ MF; X[B]=EX(X[B]); X[B+1]=EX(X[B+1]); X[B+2]=EX(X[B+2]); X[B+3]=EX(X[B+3]); PIN(X); SBAR(); }while(0)
  #define VRD(i) do{ vlo[i]=vtr(vp_+(((i)>>2)*4096+((i)&3)*1024)); vhi[i]=vtr(vp_+(((i)>>2)*4096+((i)&3)*1024+512)); }while(0)
  #define KRD(G,j) do{ if(G){ kload2(kf,kp0+sl_next,j); SBAR(); } }while(0)
  #define STEP(C0,C1,P0,P1,t,GK,GV,GL) do{ SBAR(); \
    const lds_cptr vp_=vp0+sl_prev; \
    const float bq_=hi?-mhat:1.0f; float ba0_=fbl[64*(t)], ba1_=fbl[64*(t)+32]; asm volatile("":"+v"(ba0_),"+v"(ba1_)); SBAR(); VRD(0); SBAR(); float sacc=(P0[0]+P0[1]); \
    GAPA(C0=__builtin_amdgcn_mfma_f32_32x32x16_bf16(kf[0],qr[0],__builtin_amdgcn_mfma_f32_32x32x2f32((hi?1.0f:ba0_),bq_,negm,0,0,0),0,0,0), P0[2],P0[3],P0[4],P0[5],     pw0[0]=PKW(P0,0), pw0[1]=PKW(P0,2), pw0); \
    VRD(4); SBAR(); GAPA(C1=__builtin_amdgcn_mfma_f32_32x32x16_bf16(kf[1],qr[0],__builtin_amdgcn_mfma_f32_32x32x2f32((hi?1.0f:ba1_),bq_,negm,0,0,0),0,0,0), P0[6],P0[7],P0[8],P0[9],     pw0[2]=PKW(P0,4), pw0[3]=PKW(P0,6), pw0); \
    VRD(1); SBAR(); GAPA(C0=__builtin_amdgcn_mfma_f32_32x32x16_bf16(kf[2],qr[1],C0,0,0,0),   P0[10],P0[11],P0[12],P0[13], pw1[0]=PKW(P0,8), pw1[1]=PKW(P0,10), pw1); \
    VRD(5); SBAR(); GAPA(C1=__builtin_amdgcn_mfma_f32_32x32x16_bf16(kf[3],qr[1],C1,0,0,0),   P0[14],P0[15],P1[0],P1[1],   pw1[2]=PKW(P0,12),pw1[3]=PKW(P0,14), pw1); \
    VRD(2); SBAR(); GAPA(C0=__builtin_amdgcn_mfma_f32_32x32x16_bf16(kf[4],qr[2],C0,0,0,0),   P1[2],P1[3],P1[4],P1[5],     pw2[0]=PKW(P1,0), pw2[1]=PKW(P1,2), pw2); \
    VRD(6); SBAR(); GAPA(C1=__builtin_amdgcn_mfma_f32_32x32x16_bf16(kf[5],qr[2],C1,0,0,0),   P1[6],P1[7],P1[8],P1[9],     pw2[2]=PKW(P1,4), pw2[3]=PKW(P1,6), pw2); \
    VRD(3); SBAR(); GAPA(C0=__builtin_amdgcn_mfma_f32_32x32x16_bf16(kf[6],qr[3],C0,0,0,0),   P1[10],P1[11],P1[12],P1[13], pw3[0]=PKW(P1,8), pw3[1]=PKW(P1,10), pw3); \
    VRD(7); SBAR(); GAPA(C1=__builtin_amdgcn_mfma_f32_32x32x16_bf16(kf[7],qr[3],C1,0,0,0),   P1[14],P1[15],0.f,0.f,       pw3[2]=PKW(P1,12),pw3[3]=PKW(P1,14), pw3); \
    l_reg+=sacc; \
    if(GK){DMA_K((t)+3,sl_cur);} if(GV){DMA_V((t)+1,sl_next);} \
    CMASK(C0,C1,t); \
    { float a=MX3(C0[0],C0[1],C1[0]),b=MX3(C0[2],C0[3],C1[1]); a=MX3(a,C1[2],C1[3]); \
      _Pragma("unroll") for(int r=4;r<16;r+=4){a=MX3(a,C0[r],C0[r+1]);b=MX3(b,C0[r+2],C0[r+3]);a=MX3(a,C1[r],C1[r+1]);b=MX3(b,C1[r+2],C1[r+3]);} \
      float rm=__builtin_fmaxf(a,b); { auto rr=__builtin_amdgcn_permlane32_swap(__float_as_uint(rm),__float_as_uint(rm),false,false); rm=__builtin_fmaxf(__uint_as_float(rr[0]),__uint_as_float(rr[1])); } \
      resc=false; \
      if(__builtin_expect(__any(rm>(float)THRL),0)){ const float dl=__builtin_fmaxf(rm,0.f); mhat+=dl; \
        _Pragma("unroll") for(int r=0;r<16;++r){C0[r]-=dl;C1[r]-=dl;} \
        const float f=__builtin_amdgcn_exp2f(-dl); l_reg*=f; if(hi==0)wsf[r32]=f; resc=true; } } \
    SBAR(); \
    GAPB(o[0]=__builtin_amdgcn_mfma_f32_32x32x16_bf16(PAF(0),VFR(0),o[0],0,0,0), C0,0); \
    GAPB(o[1]=__builtin_amdgcn_mfma_f32_32x32x16_bf16(PAF(0),VFR(4),o[1],0,0,0), C0,4); \
    KRD(GL,0); GAPB(o[0]=__builtin_amdgcn_mfma_f32_32x32x16_bf16(PAF(1),VFR(1),o[0],0,0,0), C0,8); \
    KRD(GL,1); GAPB(o[1]=__builtin_amdgcn_mfma_f32_32x32x16_bf16(PAF(1),VFR(5),o[1],0,0,0), C0,12); \
    KRD(GL,2); GAPB(o[0]=__builtin_amdgcn_mfma_f32_32x32x16_bf16(PAF(2),VFR(2),o[0],0,0,0), C1,0); \
    KRD(GL,3); GAPB(o[1]=__builtin_amdgcn_mfma_f32_32x32x16_bf16(PAF(2),VFR(6),o[1],0,0,0), C1,4); \
    GAPB(o[0]=__builtin_amdgcn_mfma_f32_32x32x16_bf16(PAF(3),VFR(3),o[0],0,0,0), C1,8); \
    GAPB(o[1]=__builtin_amdgcn_mfma_f32_32x32x16_bf16(PAF(3),VFR(7),o[1],0,0,0), C1,12); \
    }while(0)
  int t=1;
  #undef CMASK
  #define CMASK(P0,P1,t) do{}while(0)
  for(;t+5<NT;t+=2){
    STEP(pB0,pB1,pA0,pA1,t,true,true,true);     WAIT_BAR(2); RESC(); ROT();
    STEP(pA0,pA1,pB0,pB1,t+1,true,true,true);   WAIT_BAR(2); RESC(); ROT();
  }
  #undef CMASK
  #define CMASK(P0,P1,t) do{int jb_=(t)-(NT-4); if(jb_>=0)cmask(P0,P1,jb_,qrel,hi);}while(0)
  #define ENDW(tt) do{ if((tt)+3<NT){WAIT_BAR(2);} else if((tt)+2<NT){WAIT_BAR(1);} else {WAIT_BAR(0);} }while(0)
  for(;t+1<NT;t+=2){
    STEP(pB0,pB1,pA0,pA1,t,(t+3<NT),(t+1<NT),(t+1<NT));       ENDW(t);   RESC(); ROT();
    STEP(pA0,pA1,pB0,pB1,t+1,(t+4<NT),(t+2<NT),(t+2<NT));     ENDW(t+1); RESC(); ROT();
  }
  STEP(pB0,pB1,pA0,pA1,NT-1,false,false,false); RESC();
  { float sacc=pB0[0]+pB0[1]; _Pragma("unroll") for(int r=2;r<16;++r)sacc+=pB0[r]; _Pragma("unroll") for(int r=0;r<16;++r)sacc+=pB1[r]; l_reg+=sacc;
    pw0=(u32x4){PKW(pB0,0),PKW(pB0,2),PKW(pB0,4),PKW(pB0,6)};pw1=(u32x4){PKW(pB0,8),PKW(pB0,10),PKW(pB0,12),PKW(pB0,14)};pw2=(u32x4){PKW(pB1,0),PKW(pB1,2),PKW(pB1,4),PKW(pB1,6)};pw3=(u32x4){PKW(pB1,8),PKW(pB1,10),PKW(pB1,12),PKW(pB1,14)};
    SBAR(); pv(o,vb0+sl_cur,PAF(0),PAF(1),PAF(2),PAF(3)); }
  #undef PKW
  #undef PAF
  #undef VFR
  #undef PIN
  #undef MX3
  #undef GAPA
  #undef GAPB
  #undef EX
  #undef VRD
  #undef KRD
  #undef STEP
  #undef ENDW
  {auto rr=__builtin_amdgcn_permlane32_swap(__float_as_uint(l_reg),__float_as_uint(l_reg),false,false);l_reg=__uint_as_float(rr[0])+__uint_as_float(rr[1]);}
  if(hi==0)wsf[32+r32]=l_reg;asm volatile("s_waitcnt lgkmcnt(0)":::"memory");
  float rli[16];
  #pragma unroll
  for(int r=0;r<16;++r)rli[r]=__builtin_amdgcn_rcpf(wsf[32+crow(r,hi)]);
  bf16*Ow=Ou+(long)(wid*QBLK)*DM;
  asm volatile("s_waitcnt lgkmcnt(0)\n\ts_barrier":::"memory");
  { bf16*stg=(bf16*)(shm+LDS_OST)+wid*2048;
    #pragma unroll
    for(int r=0;r<16;++r){const int orow=crow(r,hi);
      #pragma unroll
      for(int d0=0;d0<2;++d0)stg[orow*64+d0*32+r32]=__float2bfloat16(o[d0][r]*rli[r]);}
    asm volatile("s_waitcnt lgkmcnt(0)":::"memory");
    #pragma unroll
    for(int i=0;i<4;++i){const int row=i*8+(lane>>3),ch=lane&7; const u32x4 v=*(const u32x4*)(stg+row*64+ch*8); if(wid*QBLK+row<nvalid)ATTN_STORE16(Ow+(long)row*DM+ch*8,v);} }
  asm volatile("s_waitcnt lgkmcnt(0)\n\ts_barrier":::"memory");
  #undef BIASMF
  #undef DMA_K
  #undef DMA_V
  #undef CMASK
  #undef START
  #undef RESC
  #undef ROT
}
constexpr int ATTN_LDS_BYTES=LDS_BYTES;
#undef SBAR
#undef WAIT_BAR
}

namespace mk {
#define LAS __attribute__((address_space(3)))
typedef unsigned short bf16_t;
typedef short bf16x8 __attribute__((ext_vector_type(8)));
typedef float f32x4 __attribute__((ext_vector_type(4)));
typedef unsigned u32x4 __attribute__((ext_vector_type(4)));
typedef unsigned u32x2 __attribute__((ext_vector_type(2)));

constexpr int DMODEL = 1024, NPROMPT = 32768, NSAMP = 256, MROWS = 33024, SEQ = 8192, NZ = 5888, DFF = 4096;
constexpr int SKV = 2304, PAST = 2048, NCHUNK = 4224;
constexpr float EPS = 1e-6f;
constexpr size_t MiB = (size_t)1 << 20;
constexpr size_t WS_WIN = 0, WS_WPA = 12 * MiB, WS_WPB = 13 * MiB, WS_WOUT = 14 * MiB, WS_WUP = 16 * MiB, WS_WDN = 24 * MiB;
constexpr size_t WS_CTL = 32 * MiB;
constexpr size_t CTL_BYTES = 4096;
constexpr size_t WS_RS1 = 106 * MiB, WS_RS2 = 170 * MiB;
constexpr size_t WS_BAR = 32 * MiB + 512 * 1024;
constexpr size_t WS_GB = 33 * MiB;
constexpr size_t WS_GCP = 36 * MiB, WS_GCS = 37 * MiB;
constexpr size_t WS_QP = 40 * MiB;
constexpr size_t WS_KP = 73 * MiB, WS_VP = 105 * MiB;
constexpr size_t WS_QS = 137 * MiB;
constexpr size_t WS_KS = 141 * MiB, WS_VS = 177 * MiB;
constexpr size_t WS_ZC = 213 * MiB;
constexpr size_t WS_GG = 310 * MiB;
constexpr size_t WS_QG = 343 * MiB, WS_KG = 376 * MiB, WS_KTG = 409 * MiB, WS_WG = 442 * MiB, WS_UTG = 475 * MiB, WS_GCG = 508 * MiB;
constexpr size_t WS_XN = 447 * MiB + MiB / 2;
constexpr size_t WS_VNT = 213 * MiB, WS_ST = 246 * MiB;
constexpr size_t WS_OG = 73 * MiB;
constexpr size_t WS_TMP = 141 * MiB, WS_MB = 213 * MiB, WS_MIX = 343 * MiB, WS_XN2 = 141 * MiB, WS_H = 213 * MiB, WS_DOWN = 40 * MiB;
constexpr size_t WS_DOWNP = 206 * MiB;
constexpr size_t WS_END = 512 * MiB;
constexpr size_t O_Y = 0, O_FKP = 33816576, O_FVP = 50593792, O_LFP = 67371008, O_SGP = 67633152, O_CVP = 67764224,
                 O_FKS = 67782656, O_FVS = 67913728, O_LFS = 68044800, O_SGS = 68046848, O_CVS = 68571136, O_END = 68644864;
constexpr int LDS_BYTES = 147456;
constexpr float C2 = 0.125f * 1.4426950408889634f;

struct Params { const float* in[22]; float* out; unsigned char* ws; int ph_lo, ph_hi; };
typedef const __attribute__((address_space(4))) Params* KP;

typedef float f32x2_t __attribute__((ext_vector_type(2))); typedef __bf16 bf16x2_t __attribute__((ext_vector_type(2)));
__device__ __forceinline__ unsigned cvtpk(float lo, float hi) { const f32x2_t v = {lo, hi}; const bf16x2_t b = __builtin_convertvector(v, bf16x2_t); return __builtin_bit_cast(unsigned, b); }
__device__ __forceinline__ float bflo(unsigned u) { return __uint_as_float(u << 16); }
__device__ __forceinline__ float bfhi(unsigned u) { return __uint_as_float(u & 0xffff0000u); }
__device__ __forceinline__ float bf2f(bf16_t h) { return __uint_as_float((unsigned)h << 16); }
__device__ __forceinline__ float sigmoidf_(float x) { return 1.0f / (1.0f + __expf(-x)); }
__device__ __forceinline__ float softplusf_(float x) { return fmaxf(x, 0.f) + log1pf(__expf(-fabsf(x))); }
__device__ __forceinline__ float wave_sum(float v) {
#pragma unroll
    for (int o = 32; o > 0; o >>= 1) v += __shfl_xor(v, o);
    return v;
}
__device__ __forceinline__ u32x4 pack8(const f32x4& a, const f32x4& b) { u32x4 w; w.x = cvtpk(a[0], a[1]); w.y = cvtpk(a[2], a[3]); w.z = cvtpk(b[0], b[1]); w.w = cvtpk(b[2], b[3]); return w; }
__device__ __forceinline__ bf16x8 ld2x8(const bf16_t* p0, const bf16_t* p1) { const u32x2 a = *(const u32x2*)p0, b = *(const u32x2*)p1; const u32x4 v = {a.x, a.y, b.x, b.y}; return __builtin_bit_cast(bf16x8, v); }
#define MFMA16(a, b, c) __builtin_amdgcn_mfma_f32_16x16x32_bf16((a), (b), (c), 0, 0, 0)

using pg8::Unit;
struct EpiIn {
    static constexpr bool PERM = true, AFTER_DRAIN = false;
    float* out; unsigned char* ws; const float* fbias; const float* alog; const float* dtb;
    __device__ __forceinline__ void emit(int pn, int row, int cl, f32x4 v0, f32x4 v1) const {
        const bool samp = row >= NPROMPT; const int sr = row - NPROMPT;
        const int c = pn * 256 + cl;
        if (pn < 2) {
            bf16_t* dst = samp ? (bf16_t*)(ws + WS_QS) + ((size_t)((sr >> 4) * 256 + (sr & 15)) * 512 + c) : (bf16_t*)(ws + WS_QP) + ((size_t)row * 512 + c);
            *(u32x4*)dst = pack8(v0 * C2, v1 * C2);
        } else if (pn < 6) {
            const bool isv = pn >= 4; const int cc = c - (isv ? 1024 : 512);
            float* fo = out + (samp ? (isv ? O_FVS : O_FKS) + (size_t)sr * 512 : (isv ? O_FVP : O_FKP) + (size_t)row * 512) + cc;
            __builtin_nontemporal_store(v0, (f32x4*)fo); __builtin_nontemporal_store(v1, (f32x4*)(fo + 4));
            bf16_t* dst = samp ? (bf16_t*)(ws + (isv ? WS_VS : WS_KS)) + ((size_t)((sr >> 4) * SKV + PAST + (sr & 15)) * 512 + cc)
                               : (bf16_t*)(ws + (isv ? WS_VP : WS_KP)) + ((size_t)row * 512 + cc);
            *(u32x4*)dst = pack8(v0, v1);
        } else if (pn < 12) {
            const int cc = c - 1536;
            *(u32x4*)((bf16_t*)(ws + WS_ZC) + ((size_t)row * 1536 + cc)) = pack8(v0, v1);
            if (samp) { const int t = sr & 15; if (t >= 13) { float* fo = out + O_CVS + (size_t)((sr >> 4) * 3 + t - 13) * 1536 + cc; *(f32x4*)fo = v0; *(f32x4*)(fo + 4) = v1; } }
            else { const int t = row & 8191; if (t >= 8189) { float* fo = out + O_CVP + (size_t)((row >> 13) * 3 + t - 8189) * 1536 + cc; *(f32x4*)fo = v0; *(f32x4*)(fo + 4) = v1; } }
        } else if (pn < 14) {
            const int cc = c - 3072;
            *(u32x4*)((bf16_t*)(ws + WS_GG) + ((size_t)row * 512 + cc)) = pack8(v0, v1);
        } else if (pn < 22) {
            const int cc = c - 3584; f32x4 s0, s1;
#pragma unroll
            for (int e = 0; e < 4; ++e) { s0[e] = sigmoidf_(v0[e]); s1[e] = sigmoidf_(v1[e]); }
            *(u32x4*)((bf16_t*)out + ((size_t)row * 2048 + cc)) = pack8(s0, s1);
        } else {
            const int cc = c - 5632;
            if (cc == 0) { f32x4 a, b;
#pragma unroll
                for (int e = 0; e < 4; ++e) { a[e] = -softplusf_(-(v0[e] + fbias[e])); b[e] = -softplusf_(-(v1[e] + fbias[4 + e])); }
                float* fo = out + (samp ? O_LFS + (size_t)sr * 8 : O_LFP + (size_t)row * 8); *(f32x4*)fo = a; *(f32x4*)(fo + 4) = b;
            } else if (cc == 8) { f32x4 a, b;
#pragma unroll
                for (int e = 0; e < 4; ++e) { a[e] = -__expf(alog[e]) * softplusf_(v0[e] + dtb[e]); b[e] = -__expf(alog[4 + e]) * softplusf_(v1[e] + dtb[4 + e]); }
                float* fo = (float*)(ws + WS_GB) + (size_t)row * 16; *(f32x4*)fo = a; *(f32x4*)(fo + 4) = b;
            } else if (cc == 16) { f32x4 a, b;
#pragma unroll
                for (int e = 0; e < 4; ++e) { a[e] = sigmoidf_(v0[e]); b[e] = sigmoidf_(v1[e]); }
                float* fo = (float*)(ws + WS_GB) + (size_t)row * 16 + 8; *(f32x4*)fo = a; *(f32x4*)(fo + 4) = b;
            }
        }
    }
#define EPI_ROWS(PNEXPR) do { _Pragma("unroll") for (int ai = 0; ai < 2; ++ai) _Pragma("unroll") for (int m = 0; m < 4; ++m) { const int row = u.pm * 256 + ai * 128 + wr * 64 + m * 16 + fr; \
            _Pragma("unroll") for (int bj = 0; bj < 2; ++bj) emit((PNEXPR), row, bj * 128 + wc * 32 + 8 * fq, acc[ai][bj][m][0], acc[ai][bj][m][1]); } } while (0)
    __device__ __forceinline__ void operator()(const f32x4 (&acc)[2][2][4][2], const Unit& u, int wr, int wc, int fr, int fq) const {
        const int pn = u.pn;
        if (pn < 2) EPI_ROWS(pn & 1);
        else if (pn < 4) EPI_ROWS(2 + (pn & 1));
        else if (pn < 6) EPI_ROWS(4 + (pn & 1));
        else if (pn < 12) EPI_ROWS(pn < 9 ? (pn < 7 ? 6 : (pn < 8 ? 7 : 8)) : (pn < 10 ? 9 : (pn < 11 ? 10 : 11)));
        else if (pn < 14) EPI_ROWS(12 + (pn & 1));
        else if (pn < 22) EPI_ROWS(pn < 18 ? (pn < 16 ? (pn < 15 ? 14 : 15) : (pn < 17 ? 16 : 17)) : (pn < 20 ? (pn < 19 ? 18 : 19) : (pn < 21 ? 20 : 21)));
        else { if (wc == 0 && fq < 3) {
#pragma unroll
            for (int ai = 0; ai < 2; ++ai)
#pragma unroll
                for (int m = 0; m < 4; ++m) { const int row = u.pm * 256 + ai * 128 + wr * 64 + m * 16 + fr; emit(22, row, 8 * fq, acc[ai][0][m][0], acc[ai][0][m][1]); } } }
    }
#undef EPI_ROWS
};
template <int MODE> struct EpiBf {
    static constexpr bool PERM = true, AFTER_DRAIN = false;
    float* out; unsigned char* ws;
    __device__ __forceinline__ void operator()(const f32x4 (&acc)[2][2][4][2], const Unit& u, int wr, int wc, int fr, int fq) const {
#pragma unroll
        for (int ai = 0; ai < 2; ++ai)
#pragma unroll
            for (int m = 0; m < 4; ++m) { const int row = u.pm * 256 + ai * 128 + wr * 64 + m * 16 + fr;
#pragma unroll
                for (int bj = 0; bj < 2; ++bj) { const int c = u.pn * 256 + bj * 128 + wc * 32 + 8 * fq; f32x4 v0 = acc[ai][bj][m][0], v1 = acc[ai][bj][m][1];
                    if (MODE == 2) {
#pragma unroll
                        for (int e = 0; e < 4; ++e) { const float a = fmaxf(v0[e], 0.f), b = fmaxf(v1[e], 0.f); v0[e] = a * a; v1[e] = b * b; }
                        __builtin_nontemporal_store(pack8(v0, v1), (u32x4*)((bf16_t*)(ws + WS_H) + ((size_t)row * DFF + c)));
                    } else {
                        const u32x4 gt = *(const u32x4*)((const bf16_t*)out + ((size_t)row * 2048 + (MODE == 1 ? 1024 : 0) + c));
                        const f32x4 g0 = {bflo(gt.x), bfhi(gt.x), bflo(gt.y), bfhi(gt.y)}, g1 = {bflo(gt.z), bfhi(gt.z), bflo(gt.w), bfhi(gt.w)};
                        v0 = v0 * g0; v1 = v1 * g1;
                        bf16_t* tp = (bf16_t*)(ws + WS_TMP) + ((size_t)row * 1024 + c);
                        if (MODE == 0) *(u32x4*)tp = pack8(v0, v1);
                        else { const u32x4 t = *(const u32x4*)tp; const f32x4 t0 = {bflo(t.x), bfhi(t.x), bflo(t.y), bfhi(t.y)}, t1 = {bflo(t.z), bfhi(t.z), bflo(t.w), bfhi(t.w)};
                            *(u32x4*)((bf16_t*)(ws + WS_MB) + ((size_t)row * 1024 + c)) = pack8(v0 + t0, v1 + t1); }
                    } } }
    }
};
struct EpiF32SS {
    static constexpr bool PERM = true, AFTER_DRAIN = false;
    float* dst; float* rowss;
    __device__ __forceinline__ void operator()(const f32x4 (&acc)[2][2][4][2], const Unit& u, int wr, int wc, int fr, int fq) const {
#pragma unroll
        for (int ai = 0; ai < 2; ++ai)
#pragma unroll
            for (int m = 0; m < 4; ++m) { const int row = u.pm * 256 + ai * 128 + wr * 64 + m * 16 + fr; float s = 0.f;
#pragma unroll
                for (int bj = 0; bj < 2; ++bj) { const int c = u.pn * 256 + bj * 128 + wc * 32 + 8 * fq; const f32x4 v0 = acc[ai][bj][m][0], v1 = acc[ai][bj][m][1];
                    *(u32x4*)((bf16_t*)dst + (size_t)row * 1024 + c) = pack8(v0, v1);
#pragma unroll
                    for (int e = 0; e < 4; ++e) s += v0[e] * v0[e] + v1[e] * v1[e]; }
                s += __shfl_xor(s, 16); s += __shfl_xor(s, 32);
                if (fq == 0) rowss[(size_t)row * 16 + u.pn * 4 + wc] = s; }
    }
};

struct SplitOrder {
    int bid;
    __device__ __forceinline__ bool next(int i, Unit& u) const { if (i > 0 || bid >= 16) return false; u.pm = 128; u.pn = bid & 3; return true; }
    __device__ __forceinline__ void a_ready(const Unit&) const {}
    __device__ __forceinline__ void done(const Unit&) const {}
};
struct EpiPart {
    static constexpr bool PERM = true, AFTER_DRAIN = false;
    float* dst;
    __device__ __forceinline__ void operator()(const f32x4 (&acc)[2][2][4][2], const Unit& u, int wr, int wc, int fr, int fq) const {
#pragma unroll
        for (int ai = 0; ai < 2; ++ai)
#pragma unroll
            for (int m = 0; m < 4; ++m) { const int row = ai * 128 + wr * 64 + m * 16 + fr;
#pragma unroll
                for (int bj = 0; bj < 2; ++bj) { const int c = u.pn * 256 + bj * 128 + wc * 32 + 8 * fq; float* fo = dst + (size_t)row * 1024 + c; *(f32x4*)fo = acc[ai][bj][m][0]; *(f32x4*)(fo + 4) = acc[ai][bj][m][1]; } }
    }
};

__device__ __forceinline__ int srccol(int n) {
    if (n < 1536) return n;
    if (n < 3072) return n + 8;
    if (n < 5632) return n + 24;
    if (n < 5640) return 1536 + (n - 5632);
    if (n < 5648) return 3080 + (n - 5640);
    if (n < 5656) return 3088 + (n - 5648);
    return -1;
}
__device__ __forceinline__ void phase0(KP p, unsigned char* lds, const int mk_wid) {
    const int wid = mk_wid, tid = mk_tid(mk_wid), lane = tid & 63, nbt = gridDim.x, bidt = blockIdx.x;
    const int nbw = nbt / 2;
    const int nb = bidt < nbw ? nbw : nbt - nbw, bid = bidt < nbw ? bidt : bidt - nbw; const bool do_w = bidt < nbw, do_x = bidt >= nbw;
    unsigned* ctl = (unsigned*)(p->ws + WS_CTL);
    for (int i = bidt * 512 + tid; i < (int)(CTL_BYTES / 4); i += nbt * 512) ctl[i] = 0u;
    float* tile = (float*)lds;
    if (do_w) {
#define TDECODE(t) do { remap = false; \
        if ((t) < 1472) { src = p->in[7]; ldsrc = 5656; K = 1024; dst = (bf16_t*)(p->ws + WS_WIN); n0 = ((t) >> 4) * 64; k0 = ((t) & 15) * 64; remap = true; } \
        else if ((t) < 1600) { const int q = (t) - 1472; src = p->in[13]; ldsrc = 1024; K = 512; dst = (bf16_t*)(p->ws + WS_WPA); n0 = (q >> 3) * 64; k0 = (q & 7) * 64; } \
        else if ((t) < 1728) { const int q = (t) - 1600; src = p->in[14]; ldsrc = 1024; K = 512; dst = (bf16_t*)(p->ws + WS_WPB); n0 = (q >> 3) * 64; k0 = (q & 7) * 64; } \
        else if ((t) < 1984) { const int q = (t) - 1728; src = p->in[15]; ldsrc = 1024; K = 1024; dst = (bf16_t*)(p->ws + WS_WOUT); n0 = (q >> 4) * 64; k0 = (q & 15) * 64; } \
        else if ((t) < 3008) { const int q = (t) - 1984; src = p->in[20]; ldsrc = 4096; K = 1024; dst = (bf16_t*)(p->ws + WS_WUP); n0 = (q >> 4) * 64; k0 = (q & 15) * 64; } \
        else { const int q = (t) - 3008; src = p->in[21]; ldsrc = 1024; K = 4096; dst = (bf16_t*)(p->ws + WS_WDN); n0 = (q >> 6) * 64; k0 = (q & 63) * 64; } } while (0)
#define TLOAD(tv) do { const int nn = tid & 63; int col = n0 + nn; if (remap) col = srccol(col); \
        _Pragma("unroll") for (int i = 0; i < 8; ++i) { const int kk = (tid >> 6) + 8 * i; tv[i] = col >= 0 ? __builtin_nontemporal_load(src + (size_t)(k0 + kk) * ldsrc + col) : 0.f; } } while (0)
        const float* src; bf16_t* dst; int ldsrc, K, n0, k0; bool remap; float tv[8];
        int t = bid;
        if (t < 4032) { TDECODE(t); TLOAD(tv); }
        for (; t < 4032; t += nb) {
            bf16_t* dcur = dst; const int Kc = K, n0c = n0, k0c = k0;
            { const int nn = tid & 63;
#pragma unroll
              for (int i = 0; i < 8; ++i) { const int kk = (tid >> 6) + 8 * i; tile[kk * 65 + nn] = tv[i]; } }
            __syncthreads();
            if (t + nb < 4032) { TDECODE(t + nb); TLOAD(tv); }
            __builtin_amdgcn_sched_barrier(0);
            { const int nn = tid >> 3, kq = tid & 7; float v[8];
#pragma unroll
              for (int jx = 0; jx < 8; ++jx) v[jx] = tile[(kq * 8 + jx) * 65 + nn];
              u32x4 w; w.x = cvtpk(v[0], v[1]); w.y = cvtpk(v[2], v[3]); w.z = cvtpk(v[4], v[5]); w.w = cvtpk(v[6], v[7]);
              *(u32x4*)(dcur + (size_t)(n0c + nn) * Kc + k0c + kq * 8) = w; }
            __syncthreads();
        }
#undef TDECODE
#undef TLOAD
    }
    if (do_x) { const float* gain = p->in[16]; bf16_t* XN = (bf16_t*)(p->ws + WS_XN);
      for (int rowa = bid * 8 + wid; rowa < MROWS; rowa += 2 * nb * 8) {
          int rows[2]; rows[0] = rowa; rows[1] = rowa + nb * 8 < MROWS ? rowa + nb * 8 : rowa;
          f32x4 v[2][4];
#pragma unroll
          for (int q = 0; q < 2; ++q) { const int row = rows[q]; const float* xr = row < NPROMPT ? p->in[0] + (size_t)row * 1024 : p->in[1] + (size_t)(row - NPROMPT) * 1024;
#pragma unroll
              for (int i = 0; i < 4; ++i) v[q][i] = __builtin_nontemporal_load((const f32x4*)(xr + lane * 4 + 256 * i)); }
          __builtin_amdgcn_sched_barrier(0);
#pragma unroll
          for (int q = 0; q < 2; ++q) { const int row = rows[q]; float ss = 0.f;
#pragma unroll
              for (int i = 0; i < 4; ++i) ss += v[q][i][0] * v[q][i][0] + v[q][i][1] * v[q][i][1] + v[q][i][2] * v[q][i][2] + v[q][i][3] * v[q][i][3];
              ss = wave_sum(ss); const float rs = rsqrtf(ss * (1.0f / 1024.0f) + EPS);
#pragma unroll
              for (int i = 0; i < 4; ++i) { const f32x4 g = *(const f32x4*)(gain + lane * 4 + 256 * i); const f32x4 y = v[q][i] * rs * g;
                  u32x2 w; w.x = cvtpk(y[0], y[1]); w.y = cvtpk(y[2], y[3]); *(u32x2*)(XN + (size_t)row * 1024 + lane * 4 + 256 * i) = w; } } } }
    if (do_x) { const u32x4 z4 = {0u, 0u, 0u, 0u};
      u32x4* QS = (u32x4*)(p->ws + WS_QS);
      for (int e = bid * 512 + tid; e < 262144; e += nb * 512) QS[e] = z4; }
}

__device__ __forceinline__ void cache_convert(KP p, unsigned char* lds, const int mk_wid) {
    const int tid = mk_tid(mk_wid), nb = gridDim.x, bid = blockIdx.x;
    bf16_t* KS = (bf16_t*)(p->ws + WS_KS); bf16_t* VS = (bf16_t*)(p->ws + WS_VS);
    unsigned* ctr = (unsigned*)(p->ws + WS_CTL) + 902; volatile int* sidx = (volatile int*)(lds + 120000);
    const u32x4 z4 = {0u, 0u, 0u, 0u};
    for (int e = bid * 512 + tid; e < 245760; e += nb * 512) { const int b = e / 15360, rem = e % 15360, r = 2064 + (rem >> 6), c = (rem & 63) * 8; const size_t o = ((size_t)(b * SKV + r) * 512 + c);
        *(u32x4*)(KS + o) = z4; *(u32x4*)(VS + o) = z4; }
    for (;;) {
        if (tid == 0) *sidx = (int)atomicAdd(ctr, 1u);
        __syncthreads(); const int ch = __builtin_amdgcn_readfirstlane(*sidx); __syncthreads();
        if (ch >= 1024) break;
#pragma unroll
        for (int h2 = 0; h2 < 2; ++h2) { f32x4 kv[4], vv[4];
#pragma unroll
            for (int q = 0; q < 4; ++q) { const int e = ch * 4096 + (h2 * 4 + q) * 512 + tid; kv[q] = __builtin_nontemporal_load((const f32x4*)p->in[2] + e); vv[q] = __builtin_nontemporal_load((const f32x4*)p->in[3] + e); }
            __builtin_amdgcn_sched_barrier(0);
#pragma unroll
            for (int q = 0; q < 4; ++q) { const int e = ch * 4096 + (h2 * 4 + q) * 512 + tid; const int b = e >> 18, rem = e & 262143, r = rem >> 7, c4 = rem & 127; const size_t o = ((size_t)(b * SKV + r) * 512 + c4 * 4);
                u32x2 w; w.x = cvtpk(kv[q][0], kv[q][1]); w.y = cvtpk(kv[q][2], kv[q][3]); *(u32x2*)(KS + o) = w; w.x = cvtpk(vv[q][0], vv[q][1]); w.y = cvtpk(vv[q][2], vv[q][3]); *(u32x2*)(VS + o) = w; } }
    }
}

__device__ __forceinline__ void cumsum_unit(KP p, int cu, unsigned char* lds, const int mk_wid) {
    const int wid = mk_wid, tid = mk_tid(mk_wid), lane = tid & 63;
    float* wt = (float*)lds;
    const bool samp = cu >= 4; const int b = samp ? cu - 4 : cu; const int L = samp ? SKV : SEQ; const int nthr = L / 16;
    const float* src = nullptr;
    if (tid < nthr) { const int t0 = tid * 16;
        if (!samp) src = p->out + O_LFP + (size_t)(b * SEQ + t0) * 8;
        else if (t0 < PAST) src = p->in[4] + (size_t)(b * PAST + t0) * 8;
        else if (t0 < PAST + 16) src = p->out + O_LFS + (size_t)(b * 16) * 8; }
    float tot[8];
#pragma unroll
    for (int h = 0; h < 8; ++h) tot[h] = 0.f;
    if (src) {
#pragma unroll 4
        for (int r = 0; r < 16; ++r) { const f32x4 a = *(const f32x4*)(src + r * 8), c = *(const f32x4*)(src + r * 8 + 4);
            tot[0] += a[0]; tot[1] += a[1]; tot[2] += a[2]; tot[3] += a[3]; tot[4] += c[0]; tot[5] += c[1]; tot[6] += c[2]; tot[7] += c[3]; } }
    float pre[8];
#pragma unroll
    for (int h = 0; h < 8; ++h) { float v = tot[h];
#pragma unroll
        for (int o = 1; o < 64; o <<= 1) { const float t = __shfl_up(v, o); if (lane >= o) v += t; }
        pre[h] = v - tot[h];
        if (lane == 63) wt[wid * 8 + h] = v; }
    __syncthreads();
#pragma unroll
    for (int h = 0; h < 8; ++h) { float s = 0.f; for (int w = 0; w < wid; ++w) s += wt[w * 8 + h]; pre[h] += s; }
    if (tid < nthr) { float* G = (float*)(p->ws + (samp ? WS_GCS : WS_GCP)) + (size_t)(b * 8) * L + tid * 16;
#pragma unroll
        for (int q = 0; q < 4; ++q) { f32x4 o[8];
#pragma unroll
            for (int r = 0; r < 4; ++r) { f32x4 a = {0.f, 0.f, 0.f, 0.f}, c = a; if (src) { a = *(const f32x4*)(src + (q * 4 + r) * 8); c = *(const f32x4*)(src + (q * 4 + r) * 8 + 4); }
                pre[0] += a[0]; pre[1] += a[1]; pre[2] += a[2]; pre[3] += a[3]; pre[4] += c[0]; pre[5] += c[1]; pre[6] += c[2]; pre[7] += c[3];
#pragma unroll
                for (int h = 0; h < 8; ++h) o[h][r] = pre[h]; }
#pragma unroll
            for (int h = 0; h < 8; ++h) *(f32x4*)(G + (size_t)h * L + q * 4) = o[h]; } }
    __syncthreads();
}

__device__ __forceinline__ void norm_unit(KP p, int nu, const int mk_wid) {
    const int wid = mk_wid, tid = mk_tid(mk_wid), lane = tid & 63;
    const bool samp = nu >= 128; const int b = samp ? (nu - 128) / 9 : nu >> 5, rb = samp ? (nu - 128) % 9 : nu & 31;
    const bf16_t* Kp = samp ? (const bf16_t*)(p->ws + WS_KS) + (size_t)(b * SKV + 256 * rb + 32 * wid) * 512 : (const bf16_t*)(p->ws + WS_KP) + (size_t)(b * SEQ + 256 * rb + 32 * wid) * 512;
    const bf16_t* Qp = samp ? (const bf16_t*)(p->ws + WS_QS) + (size_t)(b * 256 + 32 * wid) * 512 : (const bf16_t*)(p->ws + WS_QP) + (size_t)(b * SEQ + 256 * rb + 32 * wid) * 512;
    const bool hasq = !samp || rb == 0;
    unsigned* NRM = (unsigned*)(p->ws + WS_CTL) + 512 + ((samp ? 32 : 0) + b * 8) * 2;
    float kmax = 0.f, qmax = 0.f;
#pragma unroll 8
    for (int r = 0; r < 32; ++r) { const u32x4 kw = *(const u32x4*)(Kp + (size_t)r * 512 + lane * 8); u32x4 qw = {0u, 0u, 0u, 0u}; if (hasq) qw = *(const u32x4*)(Qp + (size_t)r * 512 + lane * 8);
        float k2 = bflo(kw.x) * bflo(kw.x) + bfhi(kw.x) * bfhi(kw.x) + bflo(kw.y) * bflo(kw.y) + bfhi(kw.y) * bfhi(kw.y) + bflo(kw.z) * bflo(kw.z) + bfhi(kw.z) * bfhi(kw.z) + bflo(kw.w) * bflo(kw.w) + bfhi(kw.w) * bfhi(kw.w);
        float q2 = bflo(qw.x) * bflo(qw.x) + bfhi(qw.x) * bfhi(qw.x) + bflo(qw.y) * bflo(qw.y) + bfhi(qw.y) * bfhi(qw.y) + bflo(qw.z) * bflo(qw.z) + bfhi(qw.z) * bfhi(qw.z) + bflo(qw.w) * bflo(qw.w) + bfhi(qw.w) * bfhi(qw.w);
        k2 += __shfl_xor(k2, 1); k2 += __shfl_xor(k2, 2); k2 += __shfl_xor(k2, 4); q2 += __shfl_xor(q2, 1); q2 += __shfl_xor(q2, 2); q2 += __shfl_xor(q2, 4);
        kmax = fmaxf(kmax, k2); qmax = fmaxf(qmax, q2); }
    if ((lane & 7) == 0) { const int h = lane >> 3; atomicMax(NRM + h * 2 + 1, __float_as_uint(kmax)); if (hasq) atomicMax(NRM + h * 2, __float_as_uint(qmax)); }
}

__device__ __forceinline__ void sdesc(int u, int k, int& b, int& h, int& zrow0, int& tt0, int& nvalid, int& cid, bool& samp) {
    if (u < 1024) { const int bh = u >> 5, chunk = 4 * (u & 31) + k; b = bh >> 3; h = bh & 7; zrow0 = b * SEQ + 64 * chunk; tt0 = 64 * chunk; nvalid = 64; cid = bh * 128 + chunk; samp = false; }
    else { const int bh = 4 * (u - 1024) + k; b = bh >> 3; h = bh & 7; zrow0 = NPROMPT + b * 16; tt0 = 0; nvalid = 16; cid = 4096 + bh; samp = true; }
}
__device__ __forceinline__ void g1_unit(KP p, int u, unsigned char* lds, const int mk_wid) {
    const int wid = mk_wid, tid = mk_tid(mk_wid), lane = tid & 63;
    bf16_t* KB = (bf16_t*)lds;
    bf16_t* VB = (bf16_t*)(lds + 36864);
    float* LM = (float*)(lds + 73728);
    float* GC = (float*)(lds + 139264);
    float* BT = GC + 256; float* EG = BT + 256;
    const bf16_t* ZC = (const bf16_t*)(p->ws + WS_ZC);
    bf16_t* qG = (bf16_t*)(p->ws + WS_QG); bf16_t* kG = (bf16_t*)(p->ws + WS_KG); bf16_t* kTG = (bf16_t*)(p->ws + WS_KTG); bf16_t* wG = (bf16_t*)(p->ws + WS_WG); bf16_t* uTG = (bf16_t*)(p->ws + WS_UTG);
    float* gcG = (float*)(p->ws + WS_GCG); const float* GB = (const float*)(p->ws + WS_GB);
    { const int cg8 = tid & 7, tg = tid >> 3, slot = tg >> 4, c0 = 4 * (tg & 15);
      int b, h, zrow0, tt0, nvalid, cid; bool samp; sdesc(u, slot, b, h, zrow0, tt0, nvalid, cid, samp);
      u32x4 zr[3][7];
#pragma unroll
      for (int sec = 0; sec < 3; ++sec)
#pragma unroll
          for (int d = 0; d < 7; ++d) { const int cc = c0 - 3 + d; zr[sec][d] = (u32x4){0u, 0u, 0u, 0u};
              if (c0 < nvalid && tt0 + cc >= 0) zr[sec][d] = *(const u32x4*)(ZC + (size_t)(zrow0 + cc) * 1536 + sec * 512 + h * 64 + cg8 * 8); }
      __builtin_amdgcn_sched_barrier(0);
#pragma unroll
      for (int sec = 0; sec < 3; ++sec) {
          const int ch = sec * 512 + h * 64 + cg8 * 8; float o[4][8];
          if (c0 < nvalid) {
              float w[4][8], r[7][8];
#pragma unroll
              for (int i = 0; i < 4; ++i) { const f32x4 a = *(const f32x4*)(p->in[9] + i * 1536 + ch), c = *(const f32x4*)(p->in[9] + i * 1536 + ch + 4);
                  w[i][0] = a[0]; w[i][1] = a[1]; w[i][2] = a[2]; w[i][3] = a[3]; w[i][4] = c[0]; w[i][5] = c[1]; w[i][6] = c[2]; w[i][7] = c[3]; }
#pragma unroll
              for (int d = 0; d < 7; ++d) { const int cc = c0 - 3 + d, s = tt0 + cc;
                  if (s < 0) {
                      if (samp) { const float* cp = p->in[6] + (size_t)(b * 3 + 3 + s) * 1536 + ch; const f32x4 a = *(const f32x4*)cp, c = *(const f32x4*)(cp + 4);
                          r[d][0] = a[0]; r[d][1] = a[1]; r[d][2] = a[2]; r[d][3] = a[3]; r[d][4] = c[0]; r[d][5] = c[1]; r[d][6] = c[2]; r[d][7] = c[3]; }
                      else {
#pragma unroll
                          for (int e = 0; e < 8; ++e) r[d][e] = 0.f; }
                  } else { const u32x4 z = zr[sec][d];
                      r[d][0] = bflo(z.x); r[d][1] = bfhi(z.x); r[d][2] = bflo(z.y); r[d][3] = bfhi(z.y); r[d][4] = bflo(z.z); r[d][5] = bfhi(z.z); r[d][6] = bflo(z.w); r[d][7] = bfhi(z.w); } }
#pragma unroll
              for (int t = 0; t < 4; ++t)
#pragma unroll
                  for (int e = 0; e < 8; ++e) { const float y = w[0][e] * r[t][e] + w[1][e] * r[t + 1][e] + w[2][e] * r[t + 2][e] + w[3][e] * r[t + 3][e]; o[t][e] = y * sigmoidf_(y); }
          } else {
#pragma unroll
              for (int t = 0; t < 4; ++t)
#pragma unroll
                  for (int e = 0; e < 8; ++e) o[t][e] = 0.f; }
#pragma unroll
          for (int t = 0; t < 4; ++t) {
              float sc = 1.f;
              if (sec < 2) { float ss = 0.f;
#pragma unroll
                  for (int e = 0; e < 8; ++e) ss += o[t][e] * o[t][e];
                  ss += __shfl_xor(ss, 1); ss += __shfl_xor(ss, 2); ss += __shfl_xor(ss, 4);
                  sc = rsqrtf(ss + EPS) * (sec == 0 ? 0.125f : 1.0f); }
              u32x4 wv; wv.x = cvtpk(o[t][0] * sc, o[t][1] * sc); wv.y = cvtpk(o[t][2] * sc, o[t][3] * sc); wv.z = cvtpk(o[t][4] * sc, o[t][5] * sc); wv.w = cvtpk(o[t][6] * sc, o[t][7] * sc);
              const int c = c0 + t;
              if (sec == 0) *(u32x4*)(qG + (size_t)cid * 4096 + c * 64 + cg8 * 8) = wv;
              else if (sec == 1) { *(u32x4*)(KB + (slot * 64 + c) * 72 + cg8 * 8) = wv; *(u32x4*)(kG + (size_t)cid * 4096 + c * 64 + cg8 * 8) = wv; }
              else *(u32x4*)(VB + (slot * 64 + c) * 72 + cg8 * 8) = wv; } } }
    if (tid < 256) { int b, h, zrow0, tt0, nvalid, cid; bool samp; sdesc(u, wid, b, h, zrow0, tt0, nvalid, cid, samp);
        float g = 0.f, bt = 0.f; if (lane < nvalid) { g = GB[(size_t)(zrow0 + lane) * 16 + h]; bt = GB[(size_t)(zrow0 + lane) * 16 + 8 + h]; }
#pragma unroll
        for (int o = 1; o < 64; o <<= 1) { const float t = __shfl_up(g, o); if (lane >= o) g += t; }
        GC[wid * 64 + lane] = g; BT[wid * 64 + lane] = bt; EG[wid * 64 + lane] = __expf(g); gcG[(size_t)cid * 64 + lane] = g; }
    __syncthreads();
    const int slot3 = tid >> 7, col = tid & 127;
    int b3, h3, zrow3, tt3, nv3, cid3; bool samp3; sdesc(u, slot3, b3, h3, zrow3, tt3, nv3, cid3, samp3);
    float x[64];
    if (col < 64) {
#pragma unroll
        for (int i = 0; i < 64; ++i) x[i] = (i < nv3) ? bf2f(VB[(slot3 * 64 + i) * 72 + col]) * BT[slot3 * 64 + i] : 0.f;
    } else { const int dk = col - 64; const float glast = GC[slot3 * 64 + 63];
#pragma unroll
        for (int i8 = 0; i8 < 8; ++i8) { float kt[8];
#pragma unroll
            for (int e = 0; e < 8; ++e) { const int i = i8 * 8 + e; const float kv = bf2f(KB[(slot3 * 64 + i) * 72 + dk]); x[i] = kv * BT[slot3 * 64 + i] * EG[slot3 * 64 + i]; kt[e] = kv * __expf(glast - GC[slot3 * 64 + i]); }
            u32x4 wv; wv.x = cvtpk(kt[0], kt[1]); wv.y = cvtpk(kt[2], kt[3]); wv.z = cvtpk(kt[4], kt[5]); wv.w = cvtpk(kt[6], kt[7]);
            *(u32x4*)(kTG + (size_t)cid3 * 4096 + dk * 64 + i8 * 8) = wv; } }
    { const int slotw = wid >> 1, half = wid & 1, g = lane >> 4, r16 = lane & 15;
      int nvw, d0_, d1_, d2_, d3_, d4_; bool d5_; sdesc(u, slotw, d0_, d1_, d2_, d3_, nvw, d4_, d5_);
      for (int it = 2 * half; it < 2 * half + 2; ++it)
          for (int jt = 0; jt <= it && 16 * it < nvw; ++jt) { f32x4 acc = {0.f, 0.f, 0.f, 0.f};
#pragma unroll
              for (int ks = 0; ks < 2; ++ks) { const bf16x8 a = *(const bf16x8*)(KB + (slotw * 64 + 16 * it + r16) * 72 + 32 * ks + 8 * g), bb = *(const bf16x8*)(KB + (slotw * 64 + 16 * jt + r16) * 72 + 32 * ks + 8 * g);
                  acc = MFMA16(a, bb, acc); }
              const int j = 16 * jt + r16; const float gcj = GC[slotw * 64 + j];
#pragma unroll
              for (int r = 0; r < 4; ++r) { const int i = 16 * it + 4 * g + r; LM[(slotw * 64 + i) * 64 + j] = (i > j) ? acc[r] * BT[slotw * 64 + i] * __expf(GC[slotw * 64 + i] - gcj) : 0.f; } } }
    __syncthreads();
    { const float* Lr = LM + slot3 * 4096;
#pragma unroll
      for (int i = 1; i < 64; ++i) if (i < nv3) { float a = x[i];
#pragma unroll
          for (int j4 = 0; j4 < (i + 3) / 4; ++j4) { const f32x4 lv = *(const f32x4*)(Lr + i * 64 + 4 * j4);
#pragma unroll
              for (int e = 0; e < 4; ++e) if (4 * j4 + e < i) a -= lv[e] * x[4 * j4 + e]; }
          x[i] = a; } }
    if (col < 64) {
#pragma unroll
        for (int i8 = 0; i8 < 8; ++i8) { u32x4 wv; wv.x = cvtpk(x[i8 * 8], x[i8 * 8 + 1]); wv.y = cvtpk(x[i8 * 8 + 2], x[i8 * 8 + 3]); wv.z = cvtpk(x[i8 * 8 + 4], x[i8 * 8 + 5]); wv.w = cvtpk(x[i8 * 8 + 6], x[i8 * 8 + 7]);
            *(u32x4*)(uTG + (size_t)cid3 * 4096 + col * 64 + i8 * 8) = wv; }
    } else { const int dk = col - 64;
#pragma unroll
        for (int i = 0; i < 64; i += 2) { const unsigned w2 = cvtpk(x[i], x[i + 1]); VB[(slot3 * 64 + i) * 72 + dk] = (bf16_t)(w2 & 0xffffu); VB[(slot3 * 64 + i + 1) * 72 + dk] = (bf16_t)(w2 >> 16); } }
    __syncthreads();
#pragma unroll
    for (int q = 0; q < 4; ++q) { const int piece = tid + 512 * q, slotc = piece >> 9, rem = piece & 511, c = rem >> 3, pc = rem & 7;
        int b, h, zrow0, tt0, nvalid, cid; bool samp; sdesc(u, slotc, b, h, zrow0, tt0, nvalid, cid, samp);
        *(u32x4*)(wG + (size_t)cid * 4096 + c * 64 + pc * 8) = *(const u32x4*)(VB + (slotc * 64 + c) * 72 + pc * 8); }
    __syncthreads();
}

__device__ __forceinline__ void g2_task(KP p, int cid0, int nchunks, int dv0, const float* s_init, float* s_out, int lane) {
    const int g = lane >> 4, r16 = lane & 15;
    const bf16_t* wG = (const bf16_t*)(p->ws + WS_WG); const bf16_t* kTG = (const bf16_t*)(p->ws + WS_KTG); const bf16_t* uTG = (const bf16_t*)(p->ws + WS_UTG); const float* gcG = (const float*)(p->ws + WS_GCG);
    bf16_t* vnT = (bf16_t*)(p->ws + WS_VNT); bf16_t* ST = (bf16_t*)(p->ws + WS_ST);
    f32x4 S[4];
#pragma unroll
    for (int mt = 0; mt < 4; ++mt)
#pragma unroll
        for (int r = 0; r < 4; ++r) S[mt][r] = s_init ? s_init[(16 * mt + 4 * g + r) * 64 + dv0 + r16] : 0.f;
#define G2_LOAD(UU, AW, AK, GL, n_) do { const size_t cb_ = (size_t)(cid0 + (n_)) * 4096; const bf16_t* wp = wG + cb_; const bf16_t* kp = kTG + cb_; const bf16_t* up = uTG + cb_ + (dv0 + r16) * 64; \
        _Pragma("unroll") for (int mt = 0; mt < 4; ++mt) { UU[mt] = *(const u32x2*)(up + 16 * mt + 4 * g); \
            _Pragma("unroll") for (int ks = 0; ks < 2; ++ks) { AW[mt][ks] = ld2x8(wp + (16 * mt + r16) * 64 + 32 * ks + 4 * g, wp + (16 * mt + r16) * 64 + 32 * ks + 16 + 4 * g); \
                AK[mt][ks] = ld2x8(kp + (16 * mt + r16) * 64 + 32 * ks + 4 * g, kp + (16 * mt + r16) * 64 + 32 * ks + 16 + 4 * g); } } \
        GL = gcG[(size_t)(cid0 + (n_)) * 64 + 63]; } while (0)
#define G2_STEP(UU, AW, AK, GL, n_) do { const size_t cb = (size_t)(cid0 + (n_)) * 4096; f32x4 acc[4]; \
        _Pragma("unroll") for (int mt = 0; mt < 4; ++mt) acc[mt] = (f32x4){bflo(UU[mt].x), bfhi(UU[mt].x), bflo(UU[mt].y), bfhi(UU[mt].y)}; \
        const float eg = __expf(GL); \
        _Pragma("unroll") for (int mt = 0; mt < 4; ++mt) { u32x2 w; w.x = cvtpk(S[mt][0], S[mt][1]); w.y = cvtpk(S[mt][2], S[mt][3]); *(u32x2*)(ST + cb + (dv0 + r16) * 64 + 16 * mt + 4 * g) = w; } \
        bf16x8 Bs[2]; \
        _Pragma("unroll") for (int ks = 0; ks < 2; ++ks) Bs[ks] = __builtin_bit_cast(bf16x8, pack8(-S[2 * ks], -S[2 * ks + 1])); \
        _Pragma("unroll") for (int mt = 0; mt < 4; ++mt) _Pragma("unroll") for (int ks = 0; ks < 2; ++ks) acc[mt] = MFMA16(AW[mt][ks], Bs[ks], acc[mt]); \
        _Pragma("unroll") for (int mt = 0; mt < 4; ++mt) { u32x2 w; w.x = cvtpk(acc[mt][0], acc[mt][1]); w.y = cvtpk(acc[mt][2], acc[mt][3]); *(u32x2*)(vnT + cb + (dv0 + r16) * 64 + 16 * mt + 4 * g) = w; } \
        bf16x8 Bv[2]; \
        _Pragma("unroll") for (int ks = 0; ks < 2; ++ks) Bv[ks] = __builtin_bit_cast(bf16x8, pack8(acc[2 * ks], acc[2 * ks + 1])); \
        _Pragma("unroll") for (int mt = 0; mt < 4; ++mt) { S[mt] = S[mt] * eg; \
            _Pragma("unroll") for (int ks = 0; ks < 2; ++ks) S[mt] = MFMA16(AK[mt][ks], Bv[ks], S[mt]); } } while (0)
    u32x2 uA[4], uB[4]; bf16x8 wA[4][2], kA[4][2], wB[4][2], kB[4][2]; float gA, gB;
    G2_LOAD(uA, wA, kA, gA, 0);
    __builtin_amdgcn_sched_barrier(0);
    for (int n = 0; n < nchunks; n += 2) {
        { const int n1 = (n + 1 < nchunks) ? n + 1 : nchunks - 1; G2_LOAD(uB, wB, kB, gB, n1); }
        __builtin_amdgcn_sched_barrier(0);
        G2_STEP(uA, wA, kA, gA, n);
        __builtin_amdgcn_sched_barrier(0);
        { const int n2 = (n + 2 < nchunks) ? n + 2 : nchunks - 1; G2_LOAD(uA, wA, kA, gA, n2); }
        __builtin_amdgcn_sched_barrier(0);
        if (n + 1 < nchunks) G2_STEP(uB, wB, kB, gB, n + 1);
        __builtin_amdgcn_sched_barrier(0);
    }
#undef G2_LOAD
#undef G2_STEP
#pragma unroll
    for (int mt = 0; mt < 4; ++mt)
#pragma unroll
        for (int r = 0; r < 4; ++r) s_out[(16 * mt + 4 * g + r) * 64 + dv0 + r16] = S[mt][r];
}

__device__ __forceinline__ void g2_scan_lds(KP p, int s, int dv0, float* s_out, int lane, unsigned char* lds) {
    const int g = lane >> 4, r16 = lane & 15;
    const bf16_t* wG = (const bf16_t*)(p->ws + WS_WG); const bf16_t* kTG = (const bf16_t*)(p->ws + WS_KTG); const bf16_t* uTG = (const bf16_t*)(p->ws + WS_UTG); const float* gcG = (const float*)(p->ws + WS_GCG);
    bf16_t* vnT = (bf16_t*)(p->ws + WS_VNT); bf16_t* ST = (bf16_t*)(p->ws + WS_ST);
    bf16_t* Lw = (bf16_t*)lds; bf16_t* Lk = Lw + 64 * 72; bf16_t* Lu = Lk + 64 * 72;
    f32x4 S[4];
#pragma unroll
    for (int mt = 0; mt < 4; ++mt) S[mt] = (f32x4){0.f, 0.f, 0.f, 0.f};
    u32x4 rw[8], rk[8], ru[2]; float gl;
#define G2L_LOAD(n_) do { const size_t cb_ = (size_t)(s * 128 + (n_)) * 4096; \
        _Pragma("unroll") for (int q = 0; q < 8; ++q) { rw[q] = *(const u32x4*)(wG + cb_ + (size_t)(lane + 64 * q) * 8); rk[q] = *(const u32x4*)(kTG + cb_ + (size_t)(lane + 64 * q) * 8); } \
        _Pragma("unroll") for (int q = 0; q < 2; ++q) ru[q] = *(const u32x4*)(uTG + cb_ + (size_t)dv0 * 64 + (size_t)(lane + 64 * q) * 8); \
        gl = gcG[(size_t)(s * 128 + (n_)) * 64 + 63]; } while (0)
    G2L_LOAD(0);
    for (int n = 0; n < 128; ++n) { const size_t cb = (size_t)(s * 128 + n) * 4096;
#pragma unroll
        for (int q = 0; q < 8; ++q) { const int piece = lane + 64 * q; *(u32x4*)(Lw + (piece >> 3) * 72 + (piece & 7) * 8) = rw[q]; *(u32x4*)(Lk + (piece >> 3) * 72 + (piece & 7) * 8) = rk[q]; }
#pragma unroll
        for (int q = 0; q < 2; ++q) { const int piece = lane + 64 * q; *(u32x4*)(Lu + (piece >> 3) * 72 + (piece & 7) * 8) = ru[q]; }
        const float eg = __expf(gl);
        __builtin_amdgcn_sched_barrier(0);
        { const int n1 = n + 1 < 128 ? n + 1 : 127; G2L_LOAD(n1); }
        __builtin_amdgcn_sched_barrier(0);
        f32x4 acc[4];
#pragma unroll
        for (int mt = 0; mt < 4; ++mt) { const u32x2 uu = *(const u32x2*)(Lu + r16 * 72 + 16 * mt + 4 * g); acc[mt] = (f32x4){bflo(uu.x), bfhi(uu.x), bflo(uu.y), bfhi(uu.y)}; }
#pragma unroll
        for (int mt = 0; mt < 4; ++mt) { u32x2 w; w.x = cvtpk(S[mt][0], S[mt][1]); w.y = cvtpk(S[mt][2], S[mt][3]); *(u32x2*)(ST + cb + (dv0 + r16) * 64 + 16 * mt + 4 * g) = w; }
        bf16x8 Bs[2];
#pragma unroll
        for (int ks = 0; ks < 2; ++ks) Bs[ks] = __builtin_bit_cast(bf16x8, pack8(-S[2 * ks], -S[2 * ks + 1]));
#pragma unroll
        for (int mt = 0; mt < 4; ++mt)
#pragma unroll
            for (int ks = 0; ks < 2; ++ks) acc[mt] = MFMA16(ld2x8(Lw + (16 * mt + r16) * 72 + 32 * ks + 4 * g, Lw + (16 * mt + r16) * 72 + 32 * ks + 16 + 4 * g), Bs[ks], acc[mt]);
#pragma unroll
        for (int mt = 0; mt < 4; ++mt) { u32x2 w; w.x = cvtpk(acc[mt][0], acc[mt][1]); w.y = cvtpk(acc[mt][2], acc[mt][3]); *(u32x2*)(vnT + cb + (dv0 + r16) * 64 + 16 * mt + 4 * g) = w; }
        bf16x8 Bv[2];
#pragma unroll
        for (int ks = 0; ks < 2; ++ks) Bv[ks] = __builtin_bit_cast(bf16x8, pack8(acc[2 * ks], acc[2 * ks + 1]));
#pragma unroll
        for (int mt = 0; mt < 4; ++mt) { S[mt] = S[mt] * eg;
#pragma unroll
            for (int ks = 0; ks < 2; ++ks) S[mt] = MFMA16(ld2x8(Lk + (16 * mt + r16) * 72 + 32 * ks + 4 * g, Lk + (16 * mt + r16) * 72 + 32 * ks + 16 + 4 * g), Bv[ks], S[mt]); }
        __builtin_amdgcn_sched_barrier(0);
    }
#undef G2L_LOAD
#pragma unroll
    for (int mt = 0; mt < 4; ++mt)
#pragma unroll
        for (int r = 0; r < 4; ++r) s_out[(16 * mt + 4 * g + r) * 64 + dv0 + r16] = S[mt][r];
}

__device__ __forceinline__ void phase3(KP p, unsigned char* lds, const int mk_wid) {
    using bf16 = attn_body::bf16;
    const int wid = mk_wid, tid = mk_tid(mk_wid), lane = tid & 63, bid = blockIdx.x;
    const int G = (int)gridDim.x;
    if (wid == 0) for (int task = bid; task < 128; task += G) { const int s = task >> 2; g2_scan_lds(p, s, 16 * (task & 3), p->out + O_SGP + (size_t)s * 4096, lane, lds); }
    { const int sb0 = G >= 192 ? 128 : 0;
      if (bid >= sb0) for (int wt = (bid - sb0) * 8 + wid; wt < 512; wt += (G - sb0) * 8) { const int s = wt >> 2; g2_task(p, 4096 + s, 1, 16 * (wt & 3), p->in[5] + (size_t)s * 4096, p->out + O_SGS + (size_t)s * 4096, lane); } }
    __syncthreads();
    unsigned* ctr = (unsigned*)(p->ws + WS_CTL);
    volatile int* sidx = (volatile int*)(lds + 120000);
    bf16* QP = (bf16*)(p->ws + WS_QP); const bf16* KP = (const bf16*)(p->ws + WS_KP); const bf16* VP = (const bf16*)(p->ws + WS_VP);
    const bf16* QS = (const bf16*)(p->ws + WS_QS); const bf16* KS = (const bf16*)(p->ws + WS_KS); const bf16* VS = (const bf16*)(p->ws + WS_VS);
    for (;;) {
        if (tid == 0) *sidx = (int)atomicAdd(ctr, 1u);
        __syncthreads(); const int idx = __builtin_amdgcn_readfirstlane(*sidx); __syncthreads();
        if (idx >= 1152) break;
        {
            int q0, nvalid; const bf16 *Qu, *Kh, *Vh; bf16* Ou; const float* G;
            int nidx;
            if (idx < 1024) { const int qb = 31 - (idx >> 5), bh = idx & 31, b = bh >> 3, h = bh & 7; q0 = qb * 256; nvalid = 256; nidx = bh;
                Ou = QP + ((size_t)(b * SEQ + q0) * 512 + h * 64); Qu = Ou; Kh = KP + ((size_t)b * SEQ * 512 + h * 64); Vh = VP + ((size_t)b * SEQ * 512 + h * 64); G = (const float*)(p->ws + WS_GCP) + (size_t)bh * SEQ; }
            else { const int bh = idx - 1024, b = bh >> 3, h = bh & 7; q0 = PAST; nvalid = 16; nidx = 32 + bh;
                Qu = QS + ((size_t)(b * 256) * 512 + h * 64); Kh = KS + ((size_t)b * SKV * 512 + h * 64); Vh = VS + ((size_t)b * SKV * 512 + h * 64);
                Ou = QP + ((size_t)(NPROMPT + b * 16) * 512 + h * 64); G = (const float*)(p->ws + WS_GCS) + (size_t)bh * SKV; }
            { const float* NR = (const float*)(p->ws + WS_CTL) + 512 + nidx * 2; const float thr = 41.0f + 2.02f * sqrtf(NR[0] * NR[1]);
              const int NTt = (q0 + 256) >> 6, tc = 2 * lane; const float gq = G[q0];
              bool ok = tc <= NTt - 4; if (ok && tc > 0) ok = (gq - G[64 * tc - 1]) * 1.4426950408889634f <= -thr;
              const unsigned long long mk = __ballot(ok); const int cnt = __builtin_amdgcn_readfirstlane((int)__ffsll((long long)~mk) - 1);
              const int t0 = 2 * (cnt > 0 ? cnt - 1 : 0);
              attn_body::attn_unit<60>(q0 - 64 * t0, nvalid, Qu, Kh + (size_t)t0 * 64 * 512, Vh + (size_t)t0 * 64 * 512, Ou, G + 64 * t0, (char*)lds, mk_wid); }
        }
    }
}

__device__ __forceinline__ void g3_task(KP p, int cid, int ib, int rowbase, int h, int lane) {
    const int g = lane >> 4, r16 = lane & 15, i = 16 * ib + r16; const size_t cb = (size_t)cid * 4096;
    const bf16_t* qG = (const bf16_t*)(p->ws + WS_QG) + cb; const bf16_t* kG = (const bf16_t*)(p->ws + WS_KG) + cb; const bf16_t* vnT = (const bf16_t*)(p->ws + WS_VNT) + cb; const bf16_t* ST = (const bf16_t*)(p->ws + WS_ST) + cb;
    const float* gc = (const float*)(p->ws + WS_GCG) + (size_t)cid * 64;
    bf16x8 Bq[2], Akk[4][2], Ast[4][2], Avn[4][2]; f32x4 gj[4];
#pragma unroll
    for (int ks = 0; ks < 2; ++ks) Bq[ks] = *(const bf16x8*)(qG + i * 64 + 32 * ks + 8 * g);
    const float gci = gc[i];
#pragma unroll
    for (int t4 = 0; t4 < 4; ++t4) { gj[t4] = *(const f32x4*)(gc + 16 * t4 + 4 * g);
#pragma unroll
        for (int ks = 0; ks < 2; ++ks) { Akk[t4][ks] = *(const bf16x8*)(kG + (16 * t4 + r16) * 64 + 32 * ks + 8 * g); Ast[t4][ks] = *(const bf16x8*)(ST + (16 * t4 + r16) * 64 + 32 * ks + 8 * g);
            Avn[t4][ks] = ld2x8(vnT + (16 * t4 + r16) * 64 + 32 * ks + 4 * g, vnT + (16 * t4 + r16) * 64 + 32 * ks + 16 + 4 * g); } }
    const size_t R = (size_t)(rowbase + i);
    const bf16_t* GG = (const bf16_t*)(p->ws + WS_GG) + R * 512 + h * 64; bf16_t* OG = (bf16_t*)(p->ws + WS_OG) + R * 512 + h * 64;
    u32x2 gw[4]; f32x4 ng[4];
#pragma unroll
    for (int mt = 0; mt < 4; ++mt) { gw[mt] = *(const u32x2*)(GG + 16 * mt + 4 * g); ng[mt] = *(const f32x4*)(p->in[12] + 16 * mt + 4 * g); }
    __builtin_amdgcn_sched_barrier(0);
    f32x4 P[4];
#pragma unroll
    for (int jt = 0; jt < 4; ++jt) { f32x4 acc = {0.f, 0.f, 0.f, 0.f};
#pragma unroll
        for (int ks = 0; ks < 2; ++ks) acc = MFMA16(Akk[jt][ks], Bq[ks], acc);
#pragma unroll
        for (int r = 0; r < 4; ++r) { const int j = 16 * jt + 4 * g + r; P[jt][r] = (j <= i) ? acc[r] * __expf(gci - gj[jt][r]) : 0.f; } }
    bf16x8 Bp[2];
#pragma unroll
    for (int ks = 0; ks < 2; ++ks) Bp[ks] = __builtin_bit_cast(bf16x8, pack8(P[2 * ks], P[2 * ks + 1]));
    const float egi = __expf(gci);
    f32x4 o[4]; float ss = 0.f;
#pragma unroll
    for (int mt = 0; mt < 4; ++mt) { f32x4 acc = {0.f, 0.f, 0.f, 0.f};
#pragma unroll
        for (int ks = 0; ks < 2; ++ks) acc = MFMA16(Ast[mt][ks], Bq[ks], acc);
        acc = acc * egi;
#pragma unroll
        for (int ks = 0; ks < 2; ++ks) acc = MFMA16(Avn[mt][ks], Bp[ks], acc);
        o[mt] = acc; ss += acc[0] * acc[0] + acc[1] * acc[1] + acc[2] * acc[2] + acc[3] * acc[3]; }
    ss += __shfl_xor(ss, 16); ss += __shfl_xor(ss, 32);
    const float rs = rsqrtf(ss * (1.0f / 64.0f) + EPS);
#pragma unroll
    for (int mt = 0; mt < 4; ++mt) {
        const float z0 = bflo(gw[mt].x), z1 = bfhi(gw[mt].x), z2 = bflo(gw[mt].y), z3 = bfhi(gw[mt].y);
        u32x2 w; w.x = cvtpk(o[mt][0] * rs * ng[mt][0] * z0 * sigmoidf_(z0), o[mt][1] * rs * ng[mt][1] * z1 * sigmoidf_(z1)); w.y = cvtpk(o[mt][2] * rs * ng[mt][2] * z2 * sigmoidf_(z2), o[mt][3] * rs * ng[mt][3] * z3 * sigmoidf_(z3));
        *(u32x2*)(OG + 16 * mt + 4 * g) = w; }
}
__device__ __forceinline__ void phase4(KP p, unsigned char* lds, const int mk_wid, const int nskip) {
    const int wid = mk_wid, tid = mk_tid(mk_wid), lane = tid & 63;
    const int half = wid >> 2, ib = wid & 3, t256 = tid & 255, g = lane >> 4, r16 = lane & 15;
    bf16_t* L = (bf16_t*)lds + half * (4 * 64 * 72);
    const bf16_t* Lq = L; const bf16_t* Lk = L + 64 * 72; const bf16_t* Ls = L + 2 * 64 * 72; const bf16_t* Lv = L + 3 * 64 * 72;
    u32x4 v[4][2];
#define G3_LOADV(pr_) do { const size_t cb_ = (size_t)(2 * (pr_) + half) * 4096; \
        const bf16_t* src_[4] = {(const bf16_t*)(p->ws + WS_QG) + cb_, (const bf16_t*)(p->ws + WS_KG) + cb_, (const bf16_t*)(p->ws + WS_ST) + cb_, (const bf16_t*)(p->ws + WS_VNT) + cb_}; \
        _Pragma("unroll") for (int a = 0; a < 4; ++a) _Pragma("unroll") for (int q = 0; q < 2; ++q) v[a][q] = *(const u32x4*)(src_[a] + (size_t)(t256 + 256 * q) * 8); } while (0)
    const int b4 = (int)blockIdx.x - nskip, nb4 = (int)gridDim.x - nskip;
    if (b4 < 0) return;
    if (b4 < 2112) G3_LOADV(b4);
    for (int pr = b4; pr < 2112; pr += nb4) {
        const int cid = 2 * pr + half; const bool samp = cid >= 4096;
        const int bh = samp ? cid - 4096 : cid >> 7, h = bh & 7;
        const int rowbase = samp ? NPROMPT + (bh >> 3) * 16 : (bh >> 3) * SEQ + 64 * (cid & 127);
#pragma unroll
        for (int a = 0; a < 4; ++a)
#pragma unroll
            for (int q = 0; q < 2; ++q) { const int piece = t256 + 256 * q; *(u32x4*)(L + (a * 64 + (piece >> 3)) * 72 + (piece & 7) * 8) = v[a][q]; }
        __syncthreads();
        if (pr + nb4 < 2112) G3_LOADV(pr + nb4);
        __builtin_amdgcn_sched_barrier(0);
        if (!samp || ib == 0) {
            const int i = 16 * ib + r16;
            const float* gc = (const float*)(p->ws + WS_GCG) + (size_t)cid * 64;
            const size_t R = (size_t)(rowbase + i);
            const bf16_t* GG = (const bf16_t*)(p->ws + WS_GG) + R * 512 + h * 64; bf16_t* OG = (bf16_t*)(p->ws + WS_OG) + R * 512 + h * 64;
            const float gci = gc[i]; f32x4 gj[4]; u32x2 gw[4]; f32x4 ng[4];
#pragma unroll
            for (int t4 = 0; t4 < 4; ++t4) { gj[t4] = *(const f32x4*)(gc + 16 * t4 + 4 * g); gw[t4] = *(const u32x2*)(GG + 16 * t4 + 4 * g); ng[t4] = *(const f32x4*)(p->in[12] + 16 * t4 + 4 * g); }
            bf16x8 Bq[2];
#pragma unroll
            for (int ks = 0; ks < 2; ++ks) Bq[ks] = *(const bf16x8*)(Lq + i * 72 + 32 * ks + 8 * g);
            f32x4 P[4];
#pragma unroll
            for (int jt = 0; jt < 4; ++jt) { f32x4 acc = {0.f, 0.f, 0.f, 0.f};
#pragma unroll
                for (int ks = 0; ks < 2; ++ks) acc = MFMA16(*(const bf16x8*)(Lk + (16 * jt + r16) * 72 + 32 * ks + 8 * g), Bq[ks], acc);
#pragma unroll
                for (int r = 0; r < 4; ++r) { const int j = 16 * jt + 4 * g + r; P[jt][r] = (j <= i) ? acc[r] * __expf(gci - gj[jt][r]) : 0.f; } }
            bf16x8 Bp[2];
#pragma unroll
            for (int ks = 0; ks < 2; ++ks) Bp[ks] = __builtin_bit_cast(bf16x8, pack8(P[2 * ks], P[2 * ks + 1]));
            const float egi = __expf(gci);
            f32x4 o[4]; float ss = 0.f;
#pragma unroll
            for (int mt = 0; mt < 4; ++mt) { f32x4 acc = {0.f, 0.f, 0.f, 0.f};
#pragma unroll
                for (int ks = 0; ks < 2; ++ks) acc = MFMA16(*(const bf16x8*)(Ls + (16 * mt + r16) * 72 + 32 * ks + 8 * g), Bq[ks], acc);
                acc = acc * egi;
#pragma unroll
                for (int ks = 0; ks < 2; ++ks) acc = MFMA16(ld2x8(Lv + (16 * mt + r16) * 72 + 32 * ks + 4 * g, Lv + (16 * mt + r16) * 72 + 32 * ks + 16 + 4 * g), Bp[ks], acc);
                o[mt] = acc; ss += acc[0] * acc[0] + acc[1] * acc[1] + acc[2] * acc[2] + acc[3] * acc[3]; }
            ss += __shfl_xor(ss, 16); ss += __shfl_xor(ss, 32);
            const float rs = rsqrtf(ss * (1.0f / 64.0f) + EPS);
#pragma unroll
            for (int mt = 0; mt < 4; ++mt) {
                const float z0 = bflo(gw[mt].x), z1 = bfhi(gw[mt].x), z2 = bflo(gw[mt].y), z3 = bfhi(gw[mt].y);
                u32x2 w; w.x = cvtpk(o[mt][0] * rs * ng[mt][0] * z0 * sigmoidf_(z0), o[mt][1] * rs * ng[mt][1] * z1 * sigmoidf_(z1)); w.y = cvtpk(o[mt][2] * rs * ng[mt][2] * z2 * sigmoidf_(z2), o[mt][3] * rs * ng[mt][3] * z3 * sigmoidf_(z3));
                *(u32x2*)(OG + 16 * mt + 4 * g) = w; }
        }
        __syncthreads();
    }
#undef G3_LOADV
}

__device__ __forceinline__ void phase7(KP p, const int mk_wid) {
    const int wid = mk_wid, tid = mk_tid(mk_wid), lane = tid & 63;
    const float* MIX = (const float*)(p->ws + WS_MIX); const float* RS1 = (const float*)(p->ws + WS_RS1); bf16_t* XN2 = (bf16_t*)(p->ws + WS_XN2);
    const int rstep = gridDim.x * 8;
    for (int rowa = blockIdx.x * 8 + wid; rowa < NPROMPT; rowa += 2 * rstep) {
        int rows[2]; rows[0] = rowa; rows[1] = rowa + rstep < NPROMPT ? rowa + rstep : rowa;
        f32x4 xv[2][4], mv[2][4]; float q1[2];
#pragma unroll
        for (int q = 0; q < 2; ++q) { const int row = rows[q]; const float* xr = p->in[0] + (size_t)row * 1024;
            q1[q] = RS1[(size_t)row * 16 + (lane & 15)];
#pragma unroll
            for (int i = 0; i < 4; ++i) { const int c = lane * 4 + 256 * i; xv[q][i] = __builtin_nontemporal_load((const f32x4*)(xr + c)); const u32x2 mw = __builtin_nontemporal_load((const u32x2*)((const bf16_t*)MIX + (size_t)row * 1024 + c)); mv[q][i] = (f32x4){bflo(mw.x), bfhi(mw.x), bflo(mw.y), bfhi(mw.y)}; } }
        __builtin_amdgcn_sched_barrier(0);
#pragma unroll
        for (int q = 0; q < 2; ++q) { const int row = rows[q]; float qq = q1[q]; qq += __shfl_xor(qq, 8); qq += __shfl_xor(qq, 4); qq += __shfl_xor(qq, 2); qq += __shfl_xor(qq, 1);
            const float rs1 = rsqrtf(qq * (1.0f / 1024.0f) + EPS);
            f32x4 v[4]; float ss = 0.f;
#pragma unroll
            for (int i = 0; i < 4; ++i) { const int c = lane * 4 + 256 * i; const f32x4 g = *(const f32x4*)(p->in[17] + c);
                v[i] = xv[q][i] + mv[q][i] * rs1 * g; ss += v[i][0] * v[i][0] + v[i][1] * v[i][1] + v[i][2] * v[i][2] + v[i][3] * v[i][3];
                *(f32x4*)(p->out + O_Y + (size_t)row * 1024 + c) = v[i]; }
            ss = wave_sum(ss); const float rs2 = rsqrtf(ss * (1.0f / 1024.0f) + EPS);
#pragma unroll
            for (int i = 0; i < 4; ++i) { const int c = lane * 4 + 256 * i; const f32x4 g = *(const f32x4*)(p->in[18] + c); const f32x4 y = v[i] * rs2 * g;
                u32x2 w; w.x = cvtpk(y[0], y[1]); w.y = cvtpk(y[2], y[3]); *(u32x2*)(XN2 + (size_t)row * 1024 + c) = w; } } }
    { const float* MP = (const float*)(p->ws + WS_DOWNP);
      for (int sr = blockIdx.x * 8 + wid; sr < NSAMP; sr += rstep) { f32x4 m[4]; float qq = 0.f;
#pragma unroll
          for (int i = 0; i < 4; ++i) { const size_t o = (size_t)sr * 1024 + lane * 4 + 256 * i;
              m[i] = ((*(const f32x4*)(MP + o) + *(const f32x4*)(MP + 262144 + o)) + *(const f32x4*)(MP + 2 * 262144 + o)) + *(const f32x4*)(MP + 3 * 262144 + o);
              qq += m[i][0] * m[i][0] + m[i][1] * m[i][1] + m[i][2] * m[i][2] + m[i][3] * m[i][3]; }
          qq = wave_sum(qq); const float rs1 = rsqrtf(qq * (1.0f / 1024.0f) + EPS); const int row = NPROMPT + sr;
          f32x4 v[4]; float ss = 0.f;
#pragma unroll
          for (int i = 0; i < 4; ++i) { const int c = lane * 4 + 256 * i; const f32x4 x = *(const f32x4*)(p->in[1] + (size_t)sr * 1024 + c), g = *(const f32x4*)(p->in[17] + c);
              v[i] = x + m[i] * rs1 * g; ss += v[i][0] * v[i][0] + v[i][1] * v[i][1] + v[i][2] * v[i][2] + v[i][3] * v[i][3];
              *(f32x4*)(p->out + O_Y + (size_t)row * 1024 + c) = v[i]; }
          ss = wave_sum(ss); const float rs2 = rsqrtf(ss * (1.0f / 1024.0f) + EPS);
#pragma unroll
          for (int i = 0; i < 4; ++i) { const int c = lane * 4 + 256 * i; const f32x4 g = *(const f32x4*)(p->in[18] + c); const f32x4 y = v[i] * rs2 * g;
              u32x2 w; w.x = cvtpk(y[0], y[1]); w.y = cvtpk(y[2], y[3]); *(u32x2*)(XN2 + (size_t)row * 1024 + c) = w; } } }
}
__device__ __forceinline__ void phase10(KP p, const int mk_wid) {
    const int wid = mk_wid, tid = mk_tid(mk_wid), lane = tid & 63;
    const float* DN = (const float*)(p->ws + WS_DOWN); const float* RS2 = (const float*)(p->ws + WS_RS2); const float* DP = (const float*)(p->ws + WS_DOWNP);
    const int rstep = gridDim.x * 8;
    for (int rowa = blockIdx.x * 8 + wid; rowa < NPROMPT; rowa += 2 * rstep) {
        const int nr = rowa + rstep < NPROMPT ? 2 : 1;
        f32x4 xv[2][4], dv[2][4]; float q2[2];
#pragma unroll
        for (int q = 0; q < 2; ++q) { const int row = q < nr ? rowa + q * rstep : rowa; q2[q] = RS2[(size_t)row * 16 + (lane & 15)];
#pragma unroll
            for (int i = 0; i < 4; ++i) { const int c = lane * 4 + 256 * i; xv[q][i] = __builtin_nontemporal_load((const f32x4*)(p->out + O_Y + (size_t)row * 1024 + c)); const u32x2 dw = __builtin_nontemporal_load((const u32x2*)((const bf16_t*)DN + (size_t)row * 1024 + c)); dv[q][i] = (f32x4){bflo(dw.x), bfhi(dw.x), bflo(dw.y), bfhi(dw.y)}; } }
        __builtin_amdgcn_sched_barrier(0);
#pragma unroll
        for (int q = 0; q < 2; ++q) if (q < nr) { const int row = rowa + q * rstep; float qq = q2[q]; qq += __shfl_xor(qq, 8); qq += __shfl_xor(qq, 4); qq += __shfl_xor(qq, 2); qq += __shfl_xor(qq, 1);
            const float rs = rsqrtf(qq * (1.0f / 1024.0f) + EPS);
#pragma unroll
            for (int i = 0; i < 4; ++i) { const int c = lane * 4 + 256 * i; const f32x4 g = *(const f32x4*)(p->in[19] + c);
                __builtin_nontemporal_store(xv[q][i] + dv[q][i] * rs * g, (f32x4*)(p->out + O_Y + (size_t)row * 1024 + c)); } } }
    for (int sr = blockIdx.x * 8 + wid; sr < NSAMP; sr += rstep) { f32x4 d[4]; float ss = 0.f;
#pragma unroll
        for (int i = 0; i < 4; ++i) { const int c = lane * 4 + 256 * i; const size_t o = (size_t)sr * 1024 + c;
            d[i] = ((*(const f32x4*)(DP + o) + *(const f32x4*)(DP + 262144 + o)) + *(const f32x4*)(DP + 2 * 262144 + o)) + *(const f32x4*)(DP + 3 * 262144 + o);
            ss += d[i][0] * d[i][0] + d[i][1] * d[i][1] + d[i][2] * d[i][2] + d[i][3] * d[i][3]; }
        ss = wave_sum(ss); const float rs = rsqrtf(ss * (1.0f / 1024.0f) + EPS);
#pragma unroll
        for (int i = 0; i < 4; ++i) { const int c = lane * 4 + 256 * i; float* yp = p->out + O_Y + (size_t)(NPROMPT + sr) * 1024 + c; const f32x4 g = *(const f32x4*)(p->in[19] + c);
            *(f32x4*)yp = *(const f32x4*)yp + d[i] * rs * g; } }
}

__device__ __forceinline__ void gbar(unsigned* cnt, unsigned nblocks, const int mk_wid) {
    __syncthreads();
    if (mk_tid(mk_wid) == 0) {
        __builtin_amdgcn_fence(__ATOMIC_RELEASE, "agent");
        const unsigned grp = blockIdx.x & 7u, gsize = (nblocks + 7u - grp) >> 3, ngrp = nblocks < 8u ? nblocks : 8u;
        if (__hip_atomic_fetch_add(cnt + 32u * (grp + 1u), 1u, __ATOMIC_RELAXED, __HIP_MEMORY_SCOPE_AGENT) + 1u == gsize) {
            __builtin_amdgcn_fence(__ATOMIC_SEQ_CST, "agent");
            __hip_atomic_fetch_add(cnt, 1u, __ATOMIC_RELAXED, __HIP_MEMORY_SCOPE_AGENT);
        }
        while (__hip_atomic_load(cnt, __ATOMIC_RELAXED, __HIP_MEMORY_SCOPE_AGENT) < ngrp) __builtin_amdgcn_s_sleep(1);
        __builtin_amdgcn_fence(__ATOMIC_ACQUIRE, "agent");
    }
    __syncthreads();
}
__global__ void __launch_bounds__(512, 2) mega(Params p_unused) {
    extern __shared__ __attribute__((aligned(16))) unsigned char lds[];
    KP p = (KP)__builtin_amdgcn_kernarg_segment_ptr();
#define FRESH() asm volatile("" : "+s"(p))
    cg::grid_group grid = cg::this_grid();
    PG8_LAS unsigned char* lds3 = (PG8_LAS unsigned char*)lds;
    const int mk_wid = __builtin_amdgcn_readfirstlane((int)(threadIdx.x >> 6));
    const int G = (int)gridDim.x, bid = (int)blockIdx.x; const int ph_lo = p->ph_lo, ph_hi = p->ph_hi;
#define IN(k) (ph_lo <= (k) && (k) < ph_hi)
#define SEAM(k) do { if ((k) + 1 < ph_hi) { if ((k) == 0) grid.sync(); else gbar((unsigned*)(p->ws + WS_BAR) + 512 * ((k) + 16 * rep_), (unsigned)G, mk_wid); } FRESH(); } while (0)
#ifndef MK_DUP
#define MK_DUP (-1)
#endif
#define REPS(k) for (int rep_ = 0; rep_ < ((MK_DUP) == (k) ? 2 : 1); ++rep_)
    if (IN(0)) REPS(0) { phase0(p, lds, mk_wid); SEAM(0); }
    if (IN(1)) REPS(1) {
        pg8::Gemm g{(const pg8::bf16_t*)(p->ws + WS_XN), (const pg8::bf16_t*)(p->ws + WS_WIN), MROWS, NZ, DMODEL, DMODEL}; pg8::StaticOrder S; S.init(MROWS, NZ, G, bid);
        EpiIn E{p->out, p->ws, p->in[8], p->in[10], p->in[11]};
        pg8::gemm_phase<EpiIn, pg8::StaticOrder, true, true>(lds3, g, S, E, mk_wid);
        __syncthreads();
        cache_convert(p, lds, mk_wid);
        SEAM(1);
    }
    if (IN(2)) REPS(2) {
        for (int u = bid; u < 20 + 272 + 1056; u += G) { if (u < 20) cumsum_unit(p, u, lds, mk_wid); else if (u < 292) norm_unit(p, u - 20, mk_wid); else g1_unit(p, u - 292, lds, mk_wid); }
        SEAM(2);
    }
    if (IN(3)) REPS(3) { phase3(p, lds, mk_wid); SEAM(3); }
    if (IN(4)) REPS(4) {
        { pg8::Gemm g{(const pg8::bf16_t*)(p->ws + WS_QP), (const pg8::bf16_t*)(p->ws + WS_WPA), MROWS, DMODEL, 512, 512}; pg8::StaticOrder S; S.init(MROWS, DMODEL, G, bid);
          EpiBf<0> E{p->out, p->ws}; pg8::gemm_phase<EpiBf<0>, pg8::StaticOrder, true, true>(lds3, g, S, E, mk_wid); }
        __syncthreads();
        phase4(p, lds, mk_wid, G > 64 ? 4 : 0); SEAM(4); }
    if (IN(5)) REPS(5) {
        { pg8::Gemm g{(const pg8::bf16_t*)(p->ws + WS_OG), (const pg8::bf16_t*)(p->ws + WS_WPB), MROWS, DMODEL, 512, 512}; pg8::StaticOrder S; S.init(MROWS, DMODEL, G, bid);
          EpiBf<1> E{p->out, p->ws}; pg8::gemm_phase<EpiBf<1>, pg8::StaticOrder, true, true>(lds3, g, S, E, mk_wid); }
        SEAM(5);
    }
    if (IN(6)) REPS(6) {
        { pg8::Gemm g{(const pg8::bf16_t*)(p->ws + WS_MB), (const pg8::bf16_t*)(p->ws + WS_WOUT), NPROMPT, DMODEL, DMODEL, DMODEL}; pg8::StaticOrder S; S.init(NPROMPT, DMODEL, G, bid);
          EpiF32SS E{(float*)(p->ws + WS_MIX), (float*)(p->ws + WS_RS1)};
          pg8::gemm_phase<EpiF32SS, pg8::StaticOrder, true, true>(lds3, g, S, E, mk_wid); }
        __syncthreads();
        { const int ks = (bid >> 2) & 3;
          pg8::Gemm g{(const pg8::bf16_t*)(p->ws + WS_MB) + ks * 256, (const pg8::bf16_t*)(p->ws + WS_WOUT) + ks * 256, MROWS, DMODEL, 256, DMODEL}; SplitOrder S{bid};
          EpiPart E{(float*)(p->ws + WS_DOWNP) + (size_t)ks * 262144};
          pg8::gemm_phase<EpiPart, SplitOrder, true, true>(lds3, g, S, E, mk_wid); }
        SEAM(6);
    }
    if (IN(7)) REPS(7) { phase7(p, mk_wid); SEAM(7); }
    if (IN(8)) REPS(8) {
        pg8::Gemm g{(const pg8::bf16_t*)(p->ws + WS_XN2), (const pg8::bf16_t*)(p->ws + WS_WUP), MROWS, DFF, DMODEL, DMODEL}; pg8::StaticOrder S; S.init(MROWS, DFF, G, bid);
        EpiBf<2> E{p->out, p->ws}; pg8::gemm_phase<EpiBf<2>, pg8::StaticOrder, true, true>(lds3, g, S, E, mk_wid);
        SEAM(8);
    }
    if (IN(9)) REPS(9) {
        { pg8::Gemm g{(const pg8::bf16_t*)(p->ws + WS_H), (const pg8::bf16_t*)(p->ws + WS_WDN), NPROMPT, DMODEL, DFF, DFF}; pg8::StaticOrder S; S.init(NPROMPT, DMODEL, G, bid);
          EpiF32SS E{(float*)(p->ws + WS_DOWN), (float*)(p->ws + WS_RS2)};
          pg8::gemm_phase<EpiF32SS, pg8::StaticOrder, true, true>(lds3, g, S, E, mk_wid); }
        __syncthreads();
        { const int ks = (bid >> 2) & 3;
          pg8::Gemm g{(const pg8::bf16_t*)(p->ws + WS_H) + ks * 1024, (const pg8::bf16_t*)(p->ws + WS_WDN) + ks * 1024, MROWS, DMODEL, 1024, DFF}; SplitOrder S{bid};
          EpiPart E{(float*)(p->ws + WS_DOWNP) + (size_t)ks * 262144};
          pg8::gemm_phase<EpiPart, SplitOrder, true, true>(lds3, g, S, E, mk_wid); }
        SEAM(9);
    }
    if (IN(10)) REPS(10) { phase10(p, mk_wid); }
#if defined(MK_DUMP_OFF)
#ifndef MK_AMP
#define MK_AMP(v) (v)
#endif
    if (IN(99)) { const bf16_t* src = (const bf16_t*)(p->ws + (size_t)(MK_DUMP_OFF)); const int tid = mk_tid(mk_wid);
        for (size_t e = (size_t)bid * 512 + tid; e < (size_t)MROWS * 1024; e += (size_t)G * 512) { const size_t row = e >> 10; const int c = (int)(e & 1023);
#if defined(MK_DUMP_F32)
            p->out[O_Y + e] = MK_AMP(((const float*)src)[e]); } }
#else
            p->out[O_Y + e] = c < (MK_DUMP_W) ? MK_AMP(bf2f(src[row * (MK_DUMP_W) + c])) : 0.f; } }
#endif
#endif
#undef IN
#undef SEAM
}
}

extern "C" void kernel_launch(void* const* d_in, const int* in_sizes, int n_in, void* d_out, int out_size, void* d_ws, size_t ws_size, hipStream_t stream) {
    using namespace mk;
    static int grid = 0;
    if (grid == 0) {
        if (n_in != 22 || (size_t)out_size != O_END || ws_size < WS_END) { fprintf(stderr, "kernel_launch: unexpected shapes: n_in %d out %d ws %zu (need %zu)\n", n_in, out_size, ws_size, (size_t)WS_END); grid = -1; return; }
        int dev = 0, cus = 0, per_cu = 0;
        if (hipGetDevice(&dev) != hipSuccess || hipDeviceGetAttribute(&cus, hipDeviceAttributeMultiprocessorCount, dev) != hipSuccess) { grid = -1; return; }
        if (hipFuncSetAttribute((const void*)mega, hipFuncAttributeMaxDynamicSharedMemorySize, LDS_BYTES) != hipSuccess) { fprintf(stderr, "kernel_launch: hipFuncSetAttribute failed\n"); grid = -1; return; }
        if (hipOccupancyMaxActiveBlocksPerMultiprocessor(&per_cu, (const void*)mega, 512, LDS_BYTES) != hipSuccess || per_cu < 1) { fprintf(stderr, "kernel_launch: occupancy query failed (%d)\n", per_cu); (void)hipGetLastError(); per_cu = 1; }
        grid = cus * 1;
    }
    if (grid < 0) return;
    (void)hipMemsetAsync((unsigned char*)d_ws + WS_BAR, 0, 65536, stream);
    Params p{};
    for (int i = 0; i < 22; ++i) p.in[i] = (const float*)d_in[i];
    p.out = (float*)d_out; p.ws = (unsigned char*)d_ws;
#if MK_PER_PHASE
    for (int ph = 0; ph < MK_PH_MAX; ++ph) { p.ph_lo = ph; p.ph_hi = ph + 1; hipLaunchKernelGGL(mega, dim3(grid), dim3(512), LDS_BYTES, stream, p); }
#if defined(MK_DUMP_OFF)
    p.ph_lo = 99; p.ph_hi = 100; hipLaunchKernelGGL(mega, dim3(grid), dim3(512), LDS_BYTES, stream, p);
#endif
#else
    p.ph_lo = 0; p.ph_hi = 11;
    void* args[] = {&p};
    hipError_t e = hipLaunchCooperativeKernel((const void*)mega, dim3(grid), dim3(512), args, LDS_BYTES, stream);
    if (e != hipSuccess) fprintf(stderr, "kernel_launch: cooperative launch failed: %s (grid %d)\n", hipGetErrorString(e), grid);
#endif
}
```
